# Optimizing an MI355X kernel written in HIP

```python
import math
import numpy as np
import jax
import jax.numpy as jnp
from jax import lax

D_MODEL = 2048
BATCH = 4
SEQ = 4096
DEPTH = 2

N_MIXERS = 2
N_A = (DEPTH + 1) // 2
N_B = DEPTH // 2
BLK = 128
EPS = 1e-6

MLA_HEADS = 16
Q_LORA = 512
KV_LORA = 512
NOPE_DIM = 128
ROPE_DIM = 64
V_DIM = 128
QK_DIM = NOPE_DIM + ROPE_DIM
ROPE_THETA = 10000.0

DIL_PAIRS = ((128, 1), (512, 4), (2048, 16))
DIL_GROUPS = len(DIL_PAIRS)
DIL_HEADS = 8
DIL_HEAD_DIM = 128
ALIBI_TOTAL_HEADS = DIL_GROUPS * DIL_HEADS

D_FF = 5632

kernel_name = "hybrid_mla_dilated_macaron"


def rmsnorm(t, g):
    tf = t.astype(jnp.float32)
    y = tf * lax.rsqrt(jnp.mean(tf * tf, axis=-1, keepdims=True) + EPS)
    return (y * g.astype(jnp.float32)).astype(t.dtype)


def swiglu(xn, w_in, w_out):
    gate, up = jnp.split(xn @ w_in, 2, axis=-1)
    return (jax.nn.silu(gate) * up) @ w_out


def rope_tables(S):
    inv = 1.0 / (ROPE_THETA ** (jnp.arange(0, ROPE_DIM, 2, dtype=jnp.float32) / ROPE_DIM))
    ang = jnp.arange(S, dtype=jnp.float32)[:, None] * inv[None, :]
    return jnp.cos(ang), jnp.sin(ang)


def apply_rope(t, cos, sin):
    t1, t2 = jnp.split(t, 2, axis=-1)
    c = cos[None, :, None, :].astype(t.dtype)
    s = sin[None, :, None, :].astype(t.dtype)
    return jnp.concatenate([t1 * c - t2 * s, t1 * s + t2 * c], axis=-1)


def mla_mixer(xn, w_down, g_cq, g_ckv, w_uq, w_ukv, g_qn, g_kn, w_o):
    B, S, _ = xn.shape
    lat = xn @ w_down
    c_q = rmsnorm(lat[..., :Q_LORA], g_cq)
    c_kv = rmsnorm(lat[..., Q_LORA:Q_LORA + KV_LORA], g_ckv)
    k_pe = lat[..., Q_LORA + KV_LORA:]
    q = (c_q @ w_uq).reshape(B, S, MLA_HEADS, QK_DIM)
    kv = (c_kv @ w_ukv).reshape(B, S, MLA_HEADS, NOPE_DIM + V_DIM)
    k_nope, v = kv[..., :NOPE_DIM], kv[..., NOPE_DIM:]
    k = jnp.concatenate(
        [k_nope, jnp.broadcast_to(k_pe[:, :, None, :], (B, S, MLA_HEADS, ROPE_DIM))], axis=-1)
    q = rmsnorm(q, g_qn)
    k = rmsnorm(k, g_kn)
    cos, sin = rope_tables(S)
    q = jnp.concatenate([q[..., :NOPE_DIM], apply_rope(q[..., NOPE_DIM:], cos, sin)], axis=-1)
    k = jnp.concatenate([k[..., :NOPE_DIM], apply_rope(k[..., NOPE_DIM:], cos, sin)], axis=-1)

    scale = 1.0 / math.sqrt(QK_DIM)
    nb = S // BLK
    qb = q.reshape(B, nb, BLK, MLA_HEADS, QK_DIM).transpose(1, 0, 2, 3, 4)
    starts = jnp.arange(nb, dtype=jnp.int32) * BLK
    kf = k.astype(jnp.float32)
    vf = v.astype(jnp.float32)
    kpos = jnp.arange(S, dtype=jnp.int32)

    def block(args):
        qblk, s0 = args
        s = jnp.einsum('bqhe,bkhe->bhqk', qblk.astype(jnp.float32), kf) * scale
        qpos = s0 + jnp.arange(BLK, dtype=jnp.int32)
        s = jnp.where((kpos[None, :] <= qpos[:, None])[None, None], s, -jnp.inf)
        p = jax.nn.softmax(s, axis=-1)
        return jnp.einsum('bhqk,bkhe->bqhe', p, vf)

    o = lax.map(block, (qb, starts))
    o = o.transpose(1, 0, 2, 3, 4).reshape(B, S, MLA_HEADS * V_DIM).astype(xn.dtype)
    return o @ w_o


def dilated_group_attn(q, k, v, window, dilation, slopes):
    B, S, H, dh = q.shape
    win_sub = window // dilation
    L = S // dilation
    Lp = -(-L // BLK) * BLK
    nb = Lp // BLK

    def to_sub(t):
        t = t.astype(jnp.float32).reshape(B, L, dilation, H, dh).transpose(0, 2, 1, 3, 4)
        return jnp.pad(t, ((0, 0), (0, 0), (0, Lp - L), (0, 0), (0, 0)))

    qb = to_sub(q).reshape(B, dilation, nb, BLK, H, dh)
    kb = to_sub(k).reshape(B, dilation, nb, BLK, H, dh)
    vb = to_sub(v).reshape(B, dilation, nb, BLK, H, dh)
    pad_prev = ((0, 0), (0, 0), (1, 0), (0, 0), (0, 0), (0, 0))
    kcat = jnp.concatenate([jnp.pad(kb, pad_prev)[:, :, :-1], kb], axis=3)
    vcat = jnp.concatenate([jnp.pad(vb, pad_prev)[:, :, :-1], vb], axis=3)

    iq = jnp.arange(BLK, dtype=jnp.int32)
    ik = jnp.arange(2 * BLK, dtype=jnp.int32)
    nidx = jnp.arange(nb, dtype=jnp.int32)
    dist = iq[:, None] + BLK - ik[None, :]
    key_ok = (nidx[:, None] * BLK - BLK + ik[None, :]) >= 0
    mask = ((dist >= 0) & (dist <= win_sub))[None] & key_ok[:, None, :]
    bias = -slopes[:, None, None] * (dilation * dist).astype(jnp.float32)[None]

    scale = 1.0 / math.sqrt(dh)
    s = jnp.einsum('bdnqhe,bdnkhe->bdnhqk', qb, kcat) * scale + bias[None, None, None]
    s = jnp.where(mask[None, None, :, None], s, -jnp.inf)
    lse = jax.nn.logsumexp(s, axis=-1)
    p = jnp.exp(s - lse[..., None])
    o = jnp.einsum('bdnhqk,bdnkhe->bdnqhe', p, vcat)

    o = o.reshape(B, dilation, Lp, H, dh)[:, :, :L].transpose(0, 2, 1, 3, 4).reshape(B, S, H, dh)
    lse = lse.transpose(0, 1, 2, 4, 3).reshape(B, dilation, Lp, H)[:, :, :L]
    lse = lse.transpose(0, 2, 1, 3).reshape(B, S, H)
    return o, lse


def alibi_slopes():
    k = np.arange(1, ALIBI_TOTAL_HEADS + 1, dtype=np.float32)
    return jnp.asarray(2.0 ** (-8.0 * k / ALIBI_TOTAL_HEADS), dtype=jnp.float32)


def dilated_mixer(xn, w_qkv, g_qn, g_kn, w_o):
    B, S, _ = xn.shape
    qkv = (xn @ w_qkv).reshape(B, S, 3, DIL_GROUPS, DIL_HEADS, DIL_HEAD_DIM)
    q = rmsnorm(qkv[:, :, 0], g_qn)
    k = rmsnorm(qkv[:, :, 1], g_kn)
    v = qkv[:, :, 2]
    slopes = alibi_slopes().reshape(DIL_GROUPS, DIL_HEADS)
    outs, lses = [], []
    for g, (window, dilation) in enumerate(DIL_PAIRS):
        o_g, lse_g = dilated_group_attn(q[:, :, g], k[:, :, g], v[:, :, g], window, dilation, slopes[g])
        outs.append(o_g)
        lses.append(lse_g)
    o = jnp.stack(outs, axis=2)
    w = jax.nn.softmax(jnp.stack(lses, axis=2), axis=2)
    o = jnp.sum(o * w[..., None], axis=2).reshape(B, S, DIL_HEADS * DIL_HEAD_DIM).astype(xn.dtype)
    return o @ w_o


def setup_inputs(seed: int = 0) -> dict:
    key = jax.random.key(seed)
    ks = iter(jax.random.split(key, 40))

    def w(shape, fan_in):
        return jax.random.normal(next(ks), shape, jnp.float32) * (fan_in ** -0.5)

    def gain(shape):
        return 1.0 + 0.02 * jax.random.normal(next(ks), shape, jnp.float32)

    D = D_MODEL
    return {
        "x": jax.random.normal(next(ks), (BATCH, SEQ, D), jnp.float32),
        "ffn1_norm": gain((DEPTH, D)),
        "ffn1_w_in": w((DEPTH, D, 2 * D_FF), D),
        "ffn1_w_out": w((DEPTH, D_FF, D), D_FF),
        "mix_norm": gain((DEPTH, D)),
        "ffn2_norm": gain((DEPTH, D)),
        "ffn2_w_in": w((DEPTH, D, 2 * D_FF), D),
        "ffn2_w_out": w((DEPTH, D_FF, D), D_FF),
        "mla_w_down": w((N_A, D, Q_LORA + KV_LORA + ROPE_DIM), D),
        "mla_g_cq": gain((N_A, Q_LORA)),
        "mla_g_ckv": gain((N_A, KV_LORA)),
        "mla_w_uq": w((N_A, Q_LORA, MLA_HEADS * QK_DIM), Q_LORA),
        "mla_w_ukv": w((N_A, KV_LORA, MLA_HEADS * (NOPE_DIM + V_DIM)), KV_LORA),
        "mla_g_qn": gain((N_A, QK_DIM)),
        "mla_g_kn": gain((N_A, QK_DIM)),
        "mla_w_o": w((N_A, MLA_HEADS * V_DIM, D), MLA_HEADS * V_DIM),
        "dil_w_qkv": w((N_B, D, 3 * DIL_GROUPS * DIL_HEADS * DIL_HEAD_DIM), D),
        "dil_g_qn": gain((N_B, DIL_HEAD_DIM)),
        "dil_g_kn": gain((N_B, DIL_HEAD_DIM)),
        "dil_w_o": w((N_B, DIL_HEADS * DIL_HEAD_DIM, D), DIL_HEADS * DIL_HEAD_DIM),
    }


def reference(x, ffn1_norm, ffn1_w_in, ffn1_w_out, mix_norm, ffn2_norm, ffn2_w_in, ffn2_w_out,
              mla_w_down, mla_g_cq, mla_g_ckv, mla_w_uq, mla_w_ukv, mla_g_qn, mla_g_kn, mla_w_o,
              dil_w_qkv, dil_g_qn, dil_g_kn, dil_w_o):
    for i in range(DEPTH):
        j = i // N_MIXERS
        x = x + 0.5 * swiglu(rmsnorm(x, ffn1_norm[i]), ffn1_w_in[i], ffn1_w_out[i])
        xn = rmsnorm(x, mix_norm[i])
        if i % N_MIXERS == 0:
            y = mla_mixer(xn, mla_w_down[j], mla_g_cq[j], mla_g_ckv[j], mla_w_uq[j], mla_w_ukv[j],
                          mla_g_qn[j], mla_g_kn[j], mla_w_o[j])
        else:
            y = dilated_mixer(xn, dil_w_qkv[j], dil_g_qn[j], dil_g_kn[j], dil_w_o[j])
        x = x + y
        x = x + 0.5 * swiglu(rmsnorm(x, ffn2_norm[i]), ffn2_w_in[i], ffn2_w_out[i])
    return x
```

```cpp
#include <hip/hip_runtime.h>
#include <hip/hip_cooperative_groups.h>
#include <cstdio>
#include <cstdint>
namespace cg = cooperative_groups;

namespace pg8 {
#define PG8_LAS __attribute__((address_space(3)))
typedef unsigned short bf16_t;
typedef short bf16x8 __attribute__((ext_vector_type(8)));
typedef float f32x4 __attribute__((ext_vector_type(4)));
typedef unsigned u32x4 __attribute__((ext_vector_type(4)));
constexpr int BM = 256, BK = 64, HALF = 128, HTB = HALF * BK * 2  , STAGE_BYTES = 8 * HTB, NXCD = 8, WGM = 8;

__host__ __device__ __forceinline__ int lds_byte(int r, int c) { const int st = (r >> 4) * 2 + (c >> 5), rr = r & 15, cc = c & 31, ob = rr * 64 + cc * 2; return st * 1024 + (ob ^ (((ob >> 9) & 1) << 5)); }
__host__ __device__ __forceinline__ void stage_rc(int b, int& R, int& C) { const int st = b / 1024, sb = b % 1024, swz = sb ^ (((sb >> 9) & 1) << 5); R = (st >> 1) * 16 + swz / 64; C = (st & 1) * 32 + (swz % 64) / 2; }
__host__ __device__ __forceinline__ int perm32(int rho) { const int n = rho >> 4, i = rho & 15; return 8 * (i >> 2) + 4 * n + (i & 3); }

struct Unit { int pm, pn; };
struct Gemm { const bf16_t* A; const bf16_t* Bt; int M, N, K; };

struct StaticOrder {
    int nM, nN, nwg, G, c;
    __host__ __device__ void init(int M, int N, int G_, int c_) { nM = M / BM; nN = N / BM; nwg = nM * nN; G = G_; c = c_; }
    __host__ __device__ bool next(int i, Unit& u) const {
        const long L = (long)i * G + c; if (L >= nwg) return false;
        int wgid = (int)L; { const int q = nwg / NXCD, r = nwg % NXCD, xcd = wgid % NXCD, off = wgid / NXCD; wgid = (xcd < r ? xcd * (q + 1) : r * (q + 1) + (xcd - r) * q) + off; }
        const int nig = WGM * nN, gid = wgid / nig, fm = gid * WGM, gsz = (nM - fm) < WGM ? (nM - fm) : WGM;
        u.pm = fm + ((wgid % nig) % gsz); u.pn = (wgid % nig) / gsz; return true;
    }
    __device__ __forceinline__ void a_ready(const Unit&) const {}
    __device__ __forceinline__ void done(const Unit&) const {}
};
struct QKVOrder {
    StaticOrder sq, skv; int G, c, nqu;
    __host__ __device__ void init(int M, int Nq, int Nkv, int G_, int c_) { sq.init(M, Nq, 1, 0); skv.init(M, Nkv, 1, 0); G = G_; c = c_; nqu = sq.nwg; }
    __host__ __device__ bool next(int i, Unit& u) const {
        const int L = i * G + c;
        if (L < nqu) return sq.next(L, u);
        if (!skv.next(L - nqu, u)) return false;
        u.pm += sq.nM; u.pn += sq.nN; return true;
    }
    __device__ __forceinline__ void a_ready(const Unit&) const {}
    __device__ __forceinline__ void done(const Unit&) const {}
};

__device__ __forceinline__ unsigned cvt_pk_bf16(float lo, float hi) { unsigned r; asm volatile("v_cvt_pk_bf16_f32 %0, %1, %2" : "=v"(r) : "v"(lo), "v"(hi)); return r; }

struct EpiBf16 {
    static constexpr bool PERM = true, AFTER_DRAIN = false;
    bf16_t* O; int ldc;
    __device__ __forceinline__ void operator()(const f32x4 (&acc)[2][2][4][2], const Unit& u, int wr, int wc, int fr, int fq) const {
        const int row0 = u.pm * BM + wr * 64 + fr; const int col0 = u.pn * BM + wc * 32 + 8 * fq;
#pragma unroll
        for (int ai = 0; ai < 2; ++ai)
#pragma unroll
            for (int m = 0; m < 4; ++m) { bf16_t* rowp = O + (size_t)(row0 + ai * HALF + m * 16) * ldc + col0;
#pragma unroll
                for (int bj = 0; bj < 2; ++bj) { const f32x4 v0 = acc[ai][bj][m][0], v1 = acc[ai][bj][m][1];
                    u32x4 w; w.x = cvt_pk_bf16(v0[0], v0[1]); w.y = cvt_pk_bf16(v0[2], v0[3]); w.z = cvt_pk_bf16(v1[0], v1[1]); w.w = cvt_pk_bf16(v1[2], v1[3]);
                    *(u32x4*)(rowp + bj * HALF) = w; } }
    }
};

__device__ __forceinline__ float silu_mul(float g, float u) { return g * __builtin_amdgcn_rcpf(1.0f + __builtin_amdgcn_exp2f(-1.4426950408889634f * g)) * u; }
struct EpiSwiGLU {
    static constexpr bool PERM = true, AFTER_DRAIN = false;
    bf16_t* H; int ldc;
    __device__ __forceinline__ void operator()(const f32x4 (&acc)[2][2][4][2], const Unit& u, int wr, int wc, int fr, int fq) const {
        const int row0 = u.pm * BM + wr * 64 + fr; const int col0 = u.pn * HALF + wc * 32 + 8 * fq;
#pragma unroll
        for (int ai = 0; ai < 2; ++ai)
#pragma unroll
            for (int m = 0; m < 4; ++m) { bf16_t* rowp = H + (size_t)(row0 + ai * HALF + m * 16) * ldc + col0;
                const f32x4 g0 = acc[ai][0][m][0], g1 = acc[ai][0][m][1], u0 = acc[ai][1][m][0], u1 = acc[ai][1][m][1];
                u32x4 w; w.x = cvt_pk_bf16(silu_mul(g0[0], u0[0]), silu_mul(g0[1], u0[1])); w.y = cvt_pk_bf16(silu_mul(g0[2], u0[2]), silu_mul(g0[3], u0[3]));
                w.z = cvt_pk_bf16(silu_mul(g1[0], u1[0]), silu_mul(g1[1], u1[1])); w.w = cvt_pk_bf16(silu_mul(g1[2], u1[2]), silu_mul(g1[3], u1[3]));
                *(u32x4*)rowp = w; }
    }
};

struct EpiRes {
    static constexpr bool PERM = false, AFTER_DRAIN = false;
    const float* base; float* out; int ldc; float s;
    __device__ __forceinline__ void operator()(const f32x4 (&acc)[2][2][4][2], const Unit& u, int wr, int wc, int fr, int fq) const {
        const int row0 = u.pm * BM + wr * 64 + fr; const int col0 = u.pn * BM + wc * 32 + 4 * fq;
#pragma unroll
        for (int ai = 0; ai < 2; ++ai)
#pragma unroll
            for (int m = 0; m < 4; ++m) { const size_t off = (size_t)(row0 + ai * HALF + m * 16) * ldc + col0;
#pragma unroll
                for (int bj = 0; bj < 2; ++bj)
#pragma unroll
                    for (int n = 0; n < 2; ++n) { const f32x4 b = *(const f32x4*)(base + off + bj * HALF + n * 16); *(f32x4*)(out + off + bj * HALF + n * 16) = b + acc[ai][bj][m][n] * s; }
                asm volatile("" ::: "memory"); }
    }
};

struct EpiF32 {
    static constexpr bool PERM = false, AFTER_DRAIN = false;
    float* out; int ldc;
    __device__ __forceinline__ void operator()(const f32x4 (&acc)[2][2][4][2], const Unit& u, int wr, int wc, int fr, int fq) const {
        const int row0 = u.pm * BM + wr * 64 + fr; const int col0 = u.pn * BM + wc * 32 + 4 * fq;
#pragma unroll
        for (int ai = 0; ai < 2; ++ai)
#pragma unroll
            for (int m = 0; m < 4; ++m) { const size_t off = (size_t)(row0 + ai * HALF + m * 16) * ldc + col0;
#pragma unroll
                for (int bj = 0; bj < 2; ++bj)
#pragma unroll
                    for (int n = 0; n < 2; ++n) *(f32x4*)(out + off + bj * HALF + n * 16) = acc[ai][bj][m][n]; }
    }
};


struct EpiQKNorm {
    static constexpr bool PERM = true, AFTER_DRAIN = false;
    bf16_t* O; int ldc; const float* gq; const float* gk; PG8_LAS float* ps; float qs;
    __device__ __forceinline__ void operator()(const f32x4 (&acc)[2][2][4][2], const Unit& u, int wr, int wc, int fr, int fq) const {
        const int row0 = u.pm * BM + wr * 64 + fr; const int col0 = u.pn * BM + wc * 32 + 8 * fq;
        if (u.pn >= 24) {
#pragma unroll
            for (int ai = 0; ai < 2; ++ai)
#pragma unroll
                for (int m = 0; m < 4; ++m) { bf16_t* rowp = O + (size_t)(row0 + ai * HALF + m * 16) * ldc + col0;
#pragma unroll
                    for (int bj = 0; bj < 2; ++bj) { const f32x4 v0 = acc[ai][bj][m][0], v1 = acc[ai][bj][m][1];
                        u32x4 w; w.x = cvt_pk_bf16(v0[0], v0[1]); w.y = cvt_pk_bf16(v0[2], v0[3]); w.z = cvt_pk_bf16(v1[0], v1[1]); w.w = cvt_pk_bf16(v1[2], v1[3]);
                        *(u32x4*)(rowp + bj * HALF) = w; } }
            return;
        }
        const bool isq = u.pn < 12; const float* g = (isq ? gq : gk) + wc * 32 + 8 * fq; const float sc = isq ? qs : 1.0f;
        const f32x4 g0 = *(const f32x4*)g, g1 = *(const f32x4*)(g + 4);
#pragma unroll
        for (int ai = 0; ai < 2; ++ai)
#pragma unroll
            for (int m = 0; m < 4; ++m)
#pragma unroll
                for (int bj = 0; bj < 2; ++bj) { const f32x4 a = acc[ai][bj][m][0], b = acc[ai][bj][m][1];
                    float s = ((a[0] * a[0] + a[1] * a[1]) + (a[2] * a[2] + a[3] * a[3])) + ((b[0] * b[0] + b[1] * b[1]) + (b[2] * b[2] + b[3] * b[3]));
                    s += __shfl_xor(s, 16); s += __shfl_xor(s, 32);
                    if (fq == 0) ps[((ai * HALF + wr * 64 + m * 16 + fr) * 2 + bj) * 4 + wc] = s; }
        asm volatile("s_waitcnt lgkmcnt(0)" ::: "memory"); __builtin_amdgcn_s_barrier(); asm volatile("" ::: "memory");
#pragma unroll
        for (int ai = 0; ai < 2; ++ai)
#pragma unroll
            for (int m = 0; m < 4; ++m) { bf16_t* rowp = O + (size_t)(row0 + ai * HALF + m * 16) * ldc + col0;
#pragma unroll
                for (int bj = 0; bj < 2; ++bj) { const f32x4 p = *(const PG8_LAS f32x4*)(ps + ((ai * HALF + wr * 64 + m * 16 + fr) * 2 + bj) * 4);
                    const float rs = __builtin_amdgcn_rsqf(((p[0] + p[1]) + (p[2] + p[3])) * (1.0f / 128.0f) + 1e-6f) * sc;
                    const f32x4 v0 = acc[ai][bj][m][0] * rs * g0, v1 = acc[ai][bj][m][1] * rs * g1;
                    u32x4 w; w.x = cvt_pk_bf16(v0[0], v0[1]); w.y = cvt_pk_bf16(v0[2], v0[3]); w.z = cvt_pk_bf16(v1[0], v1[1]); w.w = cvt_pk_bf16(v1[2], v1[3]);
                    *(u32x4*)(rowp + bj * HALF) = w; } }
        asm volatile("s_waitcnt lgkmcnt(0)" ::: "memory"); __builtin_amdgcn_s_barrier(); asm volatile("" ::: "memory");
    }
};

struct EpiQKV2 {
    static constexpr bool PERM = true, AFTER_DRAIN = false;
    bf16_t* Oq; bf16_t* Okv; int ldq, ldkv, nq, nmq;
    __device__ __forceinline__ void operator()(const f32x4 (&acc)[2][2][4][2], const Unit& u, int wr, int wc, int fr, int fq) const {
        const bool isq = u.pn < nq;
        bf16_t* O = isq ? Oq : Okv; const int ldc = isq ? ldq : ldkv; const int pm = isq ? u.pm : u.pm - nmq, pn = isq ? u.pn : u.pn - nq;
        const int row0 = pm * BM + wr * 64 + fr; const int col0 = pn * BM + wc * 32 + 8 * fq;
#pragma unroll
        for (int ai = 0; ai < 2; ++ai)
#pragma unroll
            for (int m = 0; m < 4; ++m) { bf16_t* rowp = O + (size_t)(row0 + ai * HALF + m * 16) * ldc + col0;
#pragma unroll
                for (int bj = 0; bj < 2; ++bj) { const f32x4 v0 = acc[ai][bj][m][0], v1 = acc[ai][bj][m][1];
                    u32x4 w; w.x = cvt_pk_bf16(v0[0], v0[1]); w.y = cvt_pk_bf16(v0[2], v0[3]); w.z = cvt_pk_bf16(v1[0], v1[1]); w.w = cvt_pk_bf16(v1[2], v1[3]);
                    *(u32x4*)(rowp + bj * HALF) = w; } }
    }
};
template <class Epi, class Sched, bool ALIGN_EPI = false, bool SP2 = false>
__device__ __forceinline__ void gemm_phase(PG8_LAS unsigned char* lds, const Gemm g, const Sched S, const Epi E) {
    int tid_o = threadIdx.x; asm volatile("" : "+v"(tid_o));
    const int tid = tid_o, wid = __builtin_amdgcn_readfirstlane(tid >> 6), lane = tid & 63, wr = wid >> 2, wc = wid & 3, fr = lane & 15, fq = lane >> 4;
    const int K = g.K, nt = K / BK;
    unsigned voffA[2], voffB[2];
#pragma unroll
    for (int i = 0; i < 2; ++i) { int R, C; stage_rc(tid * 16 + i * 8192, R, C); const int Rb = Epi::PERM ? ((R & ~31) + perm32(R & 31)) : R;
        voffA[i] = (unsigned)(R * K + C) * 2u; voffB[i] = (unsigned)(Rb * K + C) * 2u; }
    const size_t kstep = (size_t)(BK * 2);
    const size_t hstep = (size_t)HALF * K * 2;
    const size_t tstep = 2 * hstep;
    const unsigned ldsw = (unsigned)wid * 1024u;
    const int aoff = lds_byte(wr * 64 + fr, fq * 8), boff = lds_byte(wc * 32 + fr, fq * 8);
#define PG8_SA(b, h) (((b) * 2 + (h)) * HTB)
#define PG8_SB(b, h) ((4 + (b) * 2 + (h)) * HTB)
#define PG8_STAGE(bufoff, gbase, voff) do { _Pragma("unroll") for (int _i = 0; _i < 2; ++_i) \
        __builtin_amdgcn_global_load_lds((const unsigned*)((const char*)(gbase) + (voff)[_i]), (PG8_LAS unsigned*)(lds + (bufoff) + ldsw + _i * 8192), 16, 0, 0); } while (0)
#define PG8_LDA(dst, b, h) do { _Pragma("unroll") for (int m = 0; m < 4; ++m) _Pragma("unroll") for (int k = 0; k < 2; ++k) dst[m][k] = *(const PG8_LAS bf16x8*)(lds + PG8_SA(b, h) + aoff + m * 2048 + k * 1024); } while (0)
#define PG8_LDB(dst, b, h) do { _Pragma("unroll") for (int n = 0; n < 2; ++n) _Pragma("unroll") for (int k = 0; k < 2; ++k) dst[n][k] = *(const PG8_LAS bf16x8*)(lds + PG8_SB(b, h) + boff + n * 2048 + k * 1024); } while (0)
#define PG8_MMA(ai, bj, At, Bt) do { __builtin_amdgcn_s_setprio(1); _Pragma("unroll") for (int m = 0; m < 4; ++m) _Pragma("unroll") for (int n = 0; n < 2; ++n) _Pragma("unroll") for (int k = 0; k < 2; ++k) \
        acc[ai][bj][m][n] = __builtin_amdgcn_mfma_f32_16x16x32_bf16(Bt[n][k], At[m][k], acc[ai][bj][m][n], 0, 0, 0); __builtin_amdgcn_s_setprio(0); } while (0)
#define PG8_WAIT_V(n) asm volatile("s_waitcnt vmcnt(" #n ")" ::: "memory")
#define PG8_WAIT_L(n) asm volatile("s_waitcnt lgkmcnt(" #n ")" ::: "memory")
#define PG8_BAR __builtin_amdgcn_s_barrier()
#define PG8_SCHED __builtin_amdgcn_sched_barrier(0)
    Unit cur, nxt; int ui = 0;
    if (!S.next(0, cur)) return;
    f32x4 acc[2][2][4][2];
#pragma unroll
    for (int a = 0; a < 2; ++a)
#pragma unroll
        for (int b = 0; b < 2; ++b)
#pragma unroll
            for (int m = 0; m < 4; ++m)
#pragma unroll
                for (int n = 0; n < 2; ++n) acc[a][b][m][n] = (f32x4){0.f, 0.f, 0.f, 0.f};
    bf16x8 At[4][2], B0[2][2], B1[2][2];
    const char* cA = (const char*)g.A + (size_t)cur.pm * tstep; const char* cB = (const char*)g.Bt + (size_t)cur.pn * tstep;
    S.a_ready(cur);
    if constexpr (SP2) {
        PG8_STAGE(PG8_SB(0, 0), cB, voffB); PG8_STAGE(PG8_SB(0, 1), cB + hstep, voffB); PG8_STAGE(PG8_SA(0, 0), cA, voffA); PG8_STAGE(PG8_SA(0, 1), cA + hstep, voffA);
        if (wr == 1) PG8_BAR;
        PG8_WAIT_V(2); PG8_BAR;
        PG8_STAGE(PG8_SB(1, 0), cB + kstep, voffB); PG8_STAGE(PG8_SA(1, 0), cA + kstep, voffA); PG8_STAGE(PG8_SB(1, 1), cB + hstep + kstep, voffB);
        PG8_WAIT_V(6); PG8_BAR;
    } else {
        PG8_STAGE(PG8_SB(0, 0), cB, voffB); PG8_STAGE(PG8_SA(0, 0), cA, voffA); PG8_STAGE(PG8_SB(0, 1), cB + hstep, voffB); PG8_STAGE(PG8_SA(0, 1), cA + hstep, voffA);
        if (wr == 1) PG8_BAR;
        PG8_WAIT_V(4); PG8_BAR;
        PG8_STAGE(PG8_SB(1, 0), cB + kstep, voffB); PG8_STAGE(PG8_SA(1, 0), cA + kstep, voffA); PG8_STAGE(PG8_SB(1, 1), cB + hstep + kstep, voffB);
        PG8_WAIT_V(6); PG8_BAR;
    }
    for (;;) {
        const bool has_next = S.next(ui + 1, nxt);
        const char* nA = has_next ? (const char*)g.A + (size_t)nxt.pm * tstep : cA; const char* nB = has_next ? (const char*)g.Bt + (size_t)nxt.pn * tstep : cB;
        for (int t = 0; t < nt; t += 2) {
            const bool last = (t == nt - 2);
            const char* a1 = cA + (size_t)(t + 1) * kstep;
            const char* a2 = last ? nA : cA + (size_t)(t + 2) * kstep; const char* b2 = last ? nB : cB + (size_t)(t + 2) * kstep;
            const char* a3 = a2 + kstep; const char* b3 = b2 + kstep;
            if (last && has_next) S.a_ready(nxt);
            if constexpr (SP2) {
            PG8_LDB(B0, 0, 0); PG8_LDB(B1, 0, 1); PG8_SCHED; PG8_LDA(At, 0, 0); PG8_STAGE(PG8_SA(1, 1), a1 + hstep, voffA);
            PG8_WAIT_V(8); PG8_WAIT_L(0); PG8_BAR; PG8_MMA(0, 0, At, B0); PG8_MMA(0, 1, At, B1); PG8_BAR; PG8_SCHED;
            PG8_LDA(At, 0, 1); PG8_STAGE(PG8_SB(0, 0), b2, voffB); PG8_STAGE(PG8_SB(0, 1), b2 + hstep, voffB); PG8_STAGE(PG8_SA(0, 0), a2, voffA);
            PG8_WAIT_V(8); PG8_WAIT_L(0); PG8_BAR; PG8_MMA(1, 0, At, B0); PG8_MMA(1, 1, At, B1); PG8_BAR; PG8_SCHED;
            PG8_LDB(B0, 1, 0); PG8_LDB(B1, 1, 1); PG8_SCHED; PG8_LDA(At, 1, 0); PG8_STAGE(PG8_SA(0, 1), a2 + hstep, voffA);
            PG8_WAIT_V(8); PG8_WAIT_L(0); PG8_BAR; PG8_MMA(0, 0, At, B0); PG8_MMA(0, 1, At, B1); PG8_BAR; PG8_SCHED;
            PG8_LDA(At, 1, 1); PG8_STAGE(PG8_SB(1, 0), b3, voffB); PG8_STAGE(PG8_SB(1, 1), b3 + hstep, voffB); PG8_STAGE(PG8_SA(1, 0), a3, voffA);
            PG8_WAIT_V(8); PG8_WAIT_L(0); PG8_BAR; PG8_MMA(1, 0, At, B0); PG8_MMA(1, 1, At, B1); PG8_BAR; PG8_SCHED;
            } else {
            PG8_LDB(B0, 0, 0); PG8_SCHED; PG8_LDA(At, 0, 0); PG8_STAGE(PG8_SA(1, 1), a1 + hstep, voffA);
            PG8_WAIT_L(8); PG8_BAR; PG8_WAIT_L(0); PG8_MMA(0, 0, At, B0); PG8_BAR; PG8_SCHED;
            PG8_LDB(B1, 0, 1); PG8_STAGE(PG8_SB(0, 0), b2, voffB);
            PG8_BAR; PG8_WAIT_L(0); PG8_MMA(0, 1, At, B1); PG8_BAR;
            PG8_LDA(At, 0, 1); PG8_STAGE(PG8_SA(0, 0), a2, voffA);
            PG8_BAR; PG8_WAIT_L(0); PG8_MMA(1, 0, At, B0); PG8_BAR; PG8_SCHED;
            PG8_STAGE(PG8_SB(0, 1), b2 + hstep, voffB);
            PG8_WAIT_V(6); PG8_BAR; PG8_MMA(1, 1, At, B1); PG8_BAR;
            PG8_LDB(B0, 1, 0); PG8_SCHED; PG8_LDA(At, 1, 0); PG8_STAGE(PG8_SA(0, 1), a2 + hstep, voffA);
            PG8_WAIT_L(8); PG8_BAR; PG8_WAIT_L(0); PG8_MMA(0, 0, At, B0); PG8_BAR; PG8_SCHED;
            PG8_LDB(B1, 1, 1); PG8_STAGE(PG8_SB(1, 0), b3, voffB);
            PG8_BAR; PG8_WAIT_L(0); PG8_MMA(0, 1, At, B1); PG8_BAR;
            PG8_LDA(At, 1, 1); PG8_STAGE(PG8_SA(1, 0), a3, voffA);
            PG8_BAR; PG8_WAIT_L(0); PG8_MMA(1, 0, At, B0); PG8_BAR; PG8_SCHED;
            PG8_STAGE(PG8_SB(1, 1), b3 + hstep, voffB);
            PG8_WAIT_V(6); PG8_BAR; PG8_MMA(1, 1, At, B1); PG8_BAR;
            }
        }
        if constexpr (ALIGN_EPI) { if (wr == 0) PG8_BAR; }
        if constexpr (!Epi::AFTER_DRAIN) { E(acc, cur, wr, wc, fr, fq); S.done(cur); }
        if (!has_next) break;
#pragma unroll
        for (int a = 0; a < 2; ++a)
#pragma unroll
            for (int b = 0; b < 2; ++b)
#pragma unroll
                for (int m = 0; m < 4; ++m)
#pragma unroll
                    for (int n = 0; n < 2; ++n) acc[a][b][m][n] = (f32x4){0.f, 0.f, 0.f, 0.f};
        cur = nxt; cA = nA; cB = nB; ++ui;
        if constexpr (ALIGN_EPI) { if (wr == 1) PG8_BAR; }
    }
    PG8_WAIT_V(0);
    if constexpr (!ALIGN_EPI) { if (wr == 0) PG8_BAR; }
    PG8_BAR;
    if constexpr (Epi::AFTER_DRAIN) { E.fused(acc, cur, wr, wc, fr, fq, lds, wid, lane); S.done(cur); }
#undef PG8_SA
#undef PG8_SB
#undef PG8_STAGE
#undef PG8_LDA
#undef PG8_LDB
#undef PG8_MMA
#undef PG8_WAIT_V
#undef PG8_WAIT_L
#undef PG8_BAR
#undef PG8_SCHED
}
}

#define GAS __attribute__((address_space(1)))
#define LAS __attribute__((address_space(3)))
typedef unsigned short bf16;
typedef unsigned v4u __attribute__((ext_vector_type(4)));
typedef unsigned v2u __attribute__((ext_vector_type(2)));
typedef float f32x4 __attribute__((ext_vector_type(4)));

constexpr int NWAVES = 8;
constexpr int BATCH = 4, SEQ = 4096, D = 2048, M = BATCH * SEQ, FF = 5632;
constexpr int QL = 512, KVL = 512, NOPE = 128, ROPE = 64, VD = 128, QKD = 192, MH = 16;
constexpr int NLAT = QL + KVL + ROPE;
constexpr int NLATP = 1280;
constexpr int NQ = MH * QKD;
constexpr int KVROW = 256;
constexpr int NKV = MH * KVROW;
constexpr int DG = 3, DH = 8, DHD = 128;
constexpr int NQKV = 3 * DG * DH * DHD;
constexpr int DO = DH * DHD;
constexpr float EPS = 1e-6f;
constexpr float LOG2E = 1.4426950408889634f;

constexpr size_t MiB = 1u << 20;
constexpr size_t WS_FFN = 1 * MiB;
constexpr size_t FFN_STRIDE = 66 * MiB, FFN_WOUT = 44 * MiB;
constexpr size_t WS_DOWN = WS_FFN + 4 * FFN_STRIDE;
constexpr size_t WS_UQ = WS_DOWN + 5 * MiB;
constexpr size_t WS_UKV = WS_UQ + 3 * MiB;
constexpr size_t WS_MWO = WS_UKV + 5 * MiB;
constexpr size_t WS_DQKV = WS_MWO + 8 * MiB;
constexpr size_t WS_DWO = WS_DQKV + 36 * MiB;
constexpr size_t WS_XN = WS_DWO + 4 * MiB;
constexpr size_t WS_R = WS_XN + 64 * MiB;
constexpr size_t WS_H = WS_R;
constexpr size_t WS_LAT = WS_R;
constexpr size_t WS_CQ = WS_LAT + 80 * MiB;
constexpr size_t WS_CKV = WS_CQ + 16 * MiB;
constexpr size_t WS_Q = WS_CKV + 16 * MiB;
constexpr size_t WS_KV = WS_Q + 96 * MiB;
constexpr size_t WS_MO = WS_R;
constexpr size_t WS_QKV = WS_R;
constexpr size_t WS_DOUT = WS_QKV + 288 * MiB;
constexpr size_t WS_KPE = WS_KV + 128 * MiB;
constexpr size_t WS_END = WS_KV + 160 * MiB;
static_assert(WS_DOUT + 32 * MiB <= WS_END, "ws map");

constexpr int LDS_CTL = 131072;
constexpr int LDS_PS = LDS_CTL + 1024;
constexpr int LDS_BYTES = LDS_PS + 8192;

#define LDS_WAIT() asm volatile("s_waitcnt lgkmcnt(0)" ::: "memory")
__device__ __forceinline__ unsigned pk2(float lo, float hi) { return pg8::cvt_pk_bf16(lo, hi); }
__device__ __forceinline__ float bflo(unsigned w) { return __uint_as_float(w << 16); }
__device__ __forceinline__ float bfhi(unsigned w) { return __uint_as_float(w & 0xffff0000u); }
__device__ __forceinline__ float wave_sum(float v) {
#pragma unroll
    for (int o = 1; o < 64; o <<= 1) v += __shfl_xor(v, o);
    return v;
}

template <int MAP> __device__ __forceinline__ int map_row(int n0) {
    if (MAP == 1) { const int isup = n0 >= FF ? 1 : 0; const int c = n0 - isup * FF; return (c >> 7) * 256 + isup * 128 + (c & 127); }
    if (MAP == 2) { const int head = n0 >> 8, w = n0 & 255; return head * KVROW + (w < 128 ? w : w + 64); }
    return n0;
}
template <int MAP> __device__ __forceinline__ void conv_matrix(const float* W, int K, int N, bf16* WT, LAS float* scr, int gw, int NGW, int lane) {
    const int nblk = N / 32, nitems = (K / 64) * nblk;
    for (int it = gw; it < nitems; it += NGW) {
        const int kb = it / nblk, nb = it % nblk, k0 = 64 * kb, n0 = 32 * nb;
#pragma unroll 8
        for (int i = 0; i < 32; ++i) { const int kk = 2 * i + (lane >> 5); scr[kk * 33 + (lane & 31)] = W[(size_t)(k0 + kk) * N + n0 + (lane & 31)]; }
        LDS_WAIT(); asm volatile("" ::: "memory");
        const int c = lane & 7; const int r0 = map_row<MAP>(n0);
#pragma unroll
        for (int j = 0; j < 4; ++j) { const int n = (lane >> 3) + 8 * j; const LAS float* s = scr + (8 * c) * 33 + n;
            v4u o; o.x = pk2(s[0 * 33], s[1 * 33]); o.y = pk2(s[2 * 33], s[3 * 33]); o.z = pk2(s[4 * 33], s[5 * 33]); o.w = pk2(s[6 * 33], s[7 * 33]);
            *(v4u*)(WT + (size_t)(r0 + n) * K + k0 + 8 * c) = o; }
        LDS_WAIT(); asm volatile("" ::: "memory");
    }
}

struct Args { const float* in[20]; float* out; unsigned char* ws; int ph_lo, ph_hi; };

enum { I_X = 0, I_F1N, I_F1WI, I_F1WO, I_MIXN, I_F2N, I_F2WI, I_F2WO, I_MDOWN, I_MGCQ, I_MGCKV, I_MUQ, I_MUKV, I_MGQN, I_MGKN, I_MWO, I_DQKV, I_DGQN, I_DGKN, I_DWO };

__device__ __forceinline__ void rms_row_to_bf16(const float* xrow, const float* g, bf16* orow, int lane) {
    const f32x4* xr = (const f32x4*)xrow + lane;
    f32x4 v[8]; float s = 0.f;
#pragma unroll
    for (int j = 0; j < 8; ++j) { v[j] = xr[64 * j]; s += (v[j].x * v[j].x + v[j].y * v[j].y) + (v[j].z * v[j].z + v[j].w * v[j].w); }
    const float rs = 1.0f / sqrtf(wave_sum(s) * (1.f / D) + EPS);
    const f32x4* gr = (const f32x4*)g + lane;
    v2u* o8 = (v2u*)orow + lane;
#pragma unroll
    for (int j = 0; j < 8; ++j) { const f32x4 gg = gr[64 * j]; v2u w; w.x = pk2(v[j].x * rs * gg.x, v[j].y * rs * gg.y); w.y = pk2(v[j].z * rs * gg.z, v[j].w * rs * gg.w); o8[64 * j] = w; }
}

__device__ __forceinline__ void unpack8(const v4u w, float* f) {
    f[0] = bflo(w.x); f[1] = bfhi(w.x); f[2] = bflo(w.y); f[3] = bfhi(w.y); f[4] = bflo(w.z); f[5] = bfhi(w.z); f[6] = bflo(w.w); f[7] = bfhi(w.w);
}

__device__ __forceinline__ void mla_attn_naive_unit(const bf16* Q, const bf16* KV, bf16* O, int b, int h, int qt, int tid) {
    const int qi = tid >> 2, dq = tid & 3, q0 = qt * 128, myq = q0 + qi;
    float qv[48];
    { const v4u* qp = (const v4u*)(Q + (size_t)(b * SEQ + myq) * NQ + h * QKD + 48 * dq);
#pragma unroll
      for (int i = 0; i < 6; ++i) unpack8(qp[i], qv + 8 * i); }
    float o[32];
#pragma unroll
    for (int e = 0; e < 32; ++e) o[e] = 0.f;
    float mx = -1e30f, l = 0.f;
    const bf16* kvb = KV + (size_t)(b * SEQ) * NKV + h * KVROW;
    const int nk = q0 + 128;
#pragma unroll 1
    for (int j = 0; j < nk; ++j) {
        const bf16* kr = kvb + (size_t)j * NKV;
        const v4u* kp = (const v4u*)(kr + 48 * dq);
        float part = 0.f;
#pragma unroll
        for (int i = 0; i < 6; ++i) { float kf[8]; unpack8(kp[i], kf);
#pragma unroll
            for (int e = 0; e < 8; ++e) part += qv[8 * i + e] * kf[e]; }
        part += __shfl_xor(part, 1); part += __shfl_xor(part, 2);
        if (j <= myq) {
            const float mn = fmaxf(mx, part), corr = __builtin_amdgcn_exp2f(mx - mn), p = __builtin_amdgcn_exp2f(part - mn);
            l = l * corr + p; mx = mn;
            const v4u* vp = (const v4u*)(kr + 192 + 32 * dq);
#pragma unroll
            for (int i = 0; i < 4; ++i) { float vf[8]; unpack8(vp[i], vf);
#pragma unroll
                for (int e = 0; e < 8; ++e) o[8 * i + e] = o[8 * i + e] * corr + p * vf[e]; }
        }
    }
    const float rl = 1.0f / l;
    v4u* op = (v4u*)(O + (size_t)(b * SEQ + myq) * D + h * VD + 32 * dq);
#pragma unroll
    for (int i = 0; i < 4; ++i) { v4u w; w.x = pk2(o[8 * i] * rl, o[8 * i + 1] * rl); w.y = pk2(o[8 * i + 2] * rl, o[8 * i + 3] * rl); w.z = pk2(o[8 * i + 4] * rl, o[8 * i + 5] * rl); w.w = pk2(o[8 * i + 6] * rl, o[8 * i + 7] * rl); op[i] = w; }
}

__device__ __forceinline__ void dil_attn_naive_unit(const bf16* QKV, bf16* O, int tile, int h, int tid) {
    const int ti = tid >> 2, dq = tid & 3, tok = tile * 128 + ti, b = tok / SEQ, t = tok % SEQ;
    float o[32];
#pragma unroll
    for (int e = 0; e < 32; ++e) o[e] = 0.f;
    float mx = -1e30f, l = 0.f;
#pragma unroll 1
    for (int g = 0; g < DG; ++g) {
        const int sh = 2 * g, dil = 1 << sh;
        const float slope2 = __builtin_amdgcn_exp2f(-(float)(g * DH + h + 1) * (1.0f / 3.0f)) * (float)dil * LOG2E;
        float qv[32];
        { const v4u* qp = (const v4u*)(QKV + (size_t)tok * NQKV + g * DO + h * DHD + 32 * dq);
#pragma unroll
          for (int i = 0; i < 4; ++i) unpack8(qp[i], qv + 8 * i); }
#pragma unroll 1
        for (int j = 0; j <= 128; ++j) {
            const int pos = t - (j << sh); const bool ok = pos >= 0; const int pc = ok ? pos : 0;
            const bf16* kr = QKV + (size_t)(b * SEQ + pc) * NQKV + 3072 + g * DO + h * DHD + 32 * dq;
            const v4u* kp = (const v4u*)kr;
            float part = 0.f;
#pragma unroll
            for (int i = 0; i < 4; ++i) { float kf[8]; unpack8(kp[i], kf);
#pragma unroll
                for (int e = 0; e < 8; ++e) part += qv[8 * i + e] * kf[e]; }
            part += __shfl_xor(part, 1); part += __shfl_xor(part, 2);
            const float s = part - slope2 * (float)j;
            if (ok) {
                const float mn = fmaxf(mx, s), corr = __builtin_amdgcn_exp2f(mx - mn), p = __builtin_amdgcn_exp2f(s - mn);
                l = l * corr + p; mx = mn;
                const v4u* vp = (const v4u*)(kr + 3072);
#pragma unroll
                for (int i = 0; i < 4; ++i) { float vf[8]; unpack8(vp[i], vf);
#pragma unroll
                    for (int e = 0; e < 8; ++e) o[8 * i + e] = o[8 * i + e] * corr + p * vf[e]; }
            }
        }
    }
    const float rl = 1.0f / l;
    v4u* op = (v4u*)(O + (size_t)tok * DO + h * DHD + 32 * dq);
#pragma unroll
    for (int i = 0; i < 4; ++i) { v4u w; w.x = pk2(o[8 * i] * rl, o[8 * i + 1] * rl); w.y = pk2(o[8 * i + 2] * rl, o[8 * i + 3] * rl); w.z = pk2(o[8 * i + 4] * rl, o[8 * i + 5] * rl); w.w = pk2(o[8 * i + 6] * rl, o[8 * i + 7] * rl); op[i] = w; }
}


#define XB_TMO      128
#define XB_XCNT(j)  (256  + 64 * (j))
#define XB_XSUB(j)  (1280 + 64 * (j))
#define XB_XGEN(j)  (2304 + 64 * (j))
#define XB_TOP      3328
#define XB_TOPGEN   3392
#define XCD_BAR_WORDS 3456
#define XB_SPIN_CAP (1u << 18)

__device__ __forceinline__ unsigned xb_ld(unsigned* p)              { return __hip_atomic_load(p, __ATOMIC_RELAXED, __HIP_MEMORY_SCOPE_AGENT); }
__device__ __forceinline__ unsigned xb_add(unsigned* p, unsigned v) { return __hip_atomic_fetch_add(p, v, __ATOMIC_RELAXED, __HIP_MEMORY_SCOPE_AGENT); }
__device__ __forceinline__ unsigned xb_xcc_id() { return (unsigned)__builtin_amdgcn_s_getreg((3 << 11) | 20) & 0xFu; }
#define XB_SPIN(cond, bar) do { unsigned _sp = 0; while (cond) { __builtin_amdgcn_s_sleep(1); \
    if ((++_sp & 255u) == 0u) { if (xb_ld(&(bar)[XB_TMO])) break; if (_sp > XB_SPIN_CAP) { atomicAdd(&(bar)[XB_TMO], 1u); break; } } } } while (0)

struct XcdBarrier {
    unsigned* bar; unsigned x;
    volatile LAS unsigned* st;
};

__device__ __forceinline__ XcdBarrier xcd_barrier_post(unsigned* bar, volatile LAS unsigned* st) {
    XcdBarrier b; b.bar = bar; b.x = xb_xcc_id(); b.st = st;
    if (threadIdx.x == 0) (void)xb_add(&bar[XB_XCNT(b.x)], 1u);
    return b;
}
__device__ __forceinline__ void xcd_barrier_complete(unsigned* bar, unsigned x, unsigned& nloc, unsigned& nx) {
    const unsigned G = gridDim.x * gridDim.y * gridDim.z;
    unsigned sum, cnt, mine, sp = 0u;
    for (;;) {
        sum = 0u; cnt = 0u; mine = 0u;
#pragma unroll
        for (unsigned j = 0; j < 16; ++j) { const unsigned c = xb_ld(&bar[XB_XCNT(j)]); sum += c; cnt += (c > 0u) ? 1u : 0u; mine = (j == x) ? c : mine; }
        if (sum == G) break;
        __builtin_amdgcn_s_sleep(1);
        if ((++sp & 255u) == 0u) { if (xb_ld(&bar[XB_TMO])) break; if (sp > XB_SPIN_CAP) { atomicAdd(&bar[XB_TMO], 1u); break; } }
    }
    nloc = mine > 0u ? mine : 1u; nx = cnt > 0u ? cnt : 1u;
}

__device__ __forceinline__ void xcd_barrier(const XcdBarrier& b) {
    asm volatile("s_waitcnt vmcnt(0)" ::: "memory");
    __syncthreads();
    if (threadIdx.x == 0) {
        unsigned* bar = b.bar;
        __builtin_amdgcn_s_waitcnt(0);
        unsigned nloc = b.st[0], nx = b.st[1];
        if (nloc == 0u) { xcd_barrier_complete(bar, b.x, nloc, nx); b.st[0] = nloc; b.st[1] = nx; }
        const unsigned old = xb_add(&bar[XB_XSUB(b.x)], 1u);
        const unsigned gen = old / nloc;
        if (old + 1u == (gen + 1u) * nloc) {
            __builtin_amdgcn_fence(__ATOMIC_RELEASE, "agent");
            asm volatile("s_waitcnt vmcnt(0)" ::: "memory");
            const unsigned og = xb_add(&bar[XB_TOP], 1u);
            const unsigned tg = og / nx;
            if (og + 1u == (tg + 1u) * nx) xb_add(&bar[XB_TOPGEN], 1u);
            else XB_SPIN(xb_ld(&bar[XB_TOPGEN]) == tg, bar);
            __builtin_amdgcn_fence(__ATOMIC_ACQUIRE, "agent");
            xb_add(&bar[XB_XGEN(b.x)], 1u);
            asm volatile("s_waitcnt vmcnt(0)" ::: "memory");
        } else {
            XB_SPIN(xb_ld(&bar[XB_XGEN(b.x)]) == gen, bar);
            __builtin_amdgcn_fence(__ATOMIC_ACQUIRE, "agent");
            asm volatile("s_waitcnt vmcnt(0)" ::: "memory");
        }
    }
    __syncthreads();
}


namespace fa {
typedef short bf16x8 __attribute__((ext_vector_type(8)));
typedef short s16x4 __attribute__((ext_vector_type(4)));
typedef float f32x16 __attribute__((ext_vector_type(16)));
#define FA_MFMA(a, b, c) __builtin_amdgcn_mfma_f32_32x32x16_bf16((a), (b), (c), 0, 0, 0)
#define FA_SB() __builtin_amdgcn_sched_barrier(0)
__device__ __forceinline__ s16x4 vtr(const LAS unsigned char* p) { return __builtin_bit_cast(s16x4, __builtin_amdgcn_ds_read_tr16_b64_v4i16((LAS s16x4*)p)); }

template <int OFF> __device__ __forceinline__ void vtr8_issue(unsigned addr, s16x4 (&lo)[4], s16x4 (&hh)[4]) {
    asm volatile("ds_read_b64_tr_b16 %0, %8 offset:%c9\n\tds_read_b64_tr_b16 %1, %8 offset:%c10\n\tds_read_b64_tr_b16 %2, %8 offset:%c11\n\tds_read_b64_tr_b16 %3, %8 offset:%c12\n\t"
                 "ds_read_b64_tr_b16 %4, %8 offset:%c13\n\tds_read_b64_tr_b16 %5, %8 offset:%c14\n\tds_read_b64_tr_b16 %6, %8 offset:%c15\n\tds_read_b64_tr_b16 %7, %8 offset:%c16"
                 : "=&v"(lo[0]), "=&v"(hh[0]), "=&v"(lo[1]), "=&v"(hh[1]), "=&v"(lo[2]), "=&v"(hh[2]), "=&v"(lo[3]), "=&v"(hh[3])
                 : "v"(addr), "i"(OFF), "i"(OFF + 2048), "i"(OFF + 512), "i"(OFF + 512 + 2048), "i"(OFF + 1024), "i"(OFF + 1024 + 2048), "i"(OFF + 1536), "i"(OFF + 1536 + 2048)
                 : "memory");
}
__device__ __forceinline__ void vtr8_wait(s16x4 (&lo)[4], s16x4 (&hh)[4]) {
    asm volatile("s_waitcnt lgkmcnt(0)" : "+v"(lo[0]), "+v"(hh[0]), "+v"(lo[1]), "+v"(hh[1]), "+v"(lo[2]), "+v"(hh[2]), "+v"(lo[3]), "+v"(hh[3]) :: "memory");
}
struct Desc {
    const bf16* Q; const bf16* K; const bf16* V; const bf16* KPE; bf16* O; float* LSE;
    long qs, ks, vs, os, kps; int lses;
    int Q0, t_lo, t_hi, W; float slope2;
};
struct ST { f32x16 a, b; };

template <int DQK, bool HAS_LSE>
__device__ __forceinline__ void unit(LAS unsigned char* lds, const Desc& d) {
    constexpr int KROW = DQK * 2, KT = 64 * KROW, VT = 16384, KCH = DQK / 8, NKS = DQK / 16, KINST = KT / 8192  , NKO = (DQK == 192) ? 4 : 8;
    constexpr int LDS_V = 3 * KT;
    static_assert(LDS_V + 3 * VT <= 131072, "attention LDS");
    int tid_o = threadIdx.x; asm volatile("" : "+v"(tid_o));
    const int tid = tid_o, lane = tid & 63, r = lane & 31, hi = lane >> 5, w = __builtin_amdgcn_readfirstlane(tid >> 6);
    const int qw = d.Q0 + 32 * w, myq = qw + r;
    const float NEG = -1e30f;
    bf16x8 qr[NKS];
    { const bf16* qp = d.Q + (long)(32 * w + r) * d.qs + 8 * hi;
#pragma unroll
      for (int ks = 0; ks < NKS; ++ks) qr[ks] = *(const bf16x8*)(qp + 16 * ks); }
    f32x16 o[4];
#pragma unroll
    for (int db = 0; db < 4; ++db)
#pragma unroll
        for (int i = 0; i < 16; ++i) o[db][i] = 0.f;
    float m = NEG, l = 0.f;
    int kso[KINST], vso[2]; bool kpe_[KINST];
#pragma unroll
    for (int i = 0; i < KINST; ++i) { const int q = 64 * (KINST * w + i) + lane, row = q / KCH, pos = q % KCH;
        const int c = (DQK == 192) ? ((pos & ~7) | ((pos & 7) ^ ((row >> 1) & 7))) : (pos ^ (row & 15));
        kpe_[i] = (DQK == 192) && (c >= 16);
        kso[i] = kpe_[i] ? row * (int)d.kps + 8 * (c - 16) : row * (int)d.ks + 8 * c; }
#pragma unroll
    for (int i = 0; i < 2; ++i) { const int q = 64 * (2 * w + i) + lane, sub = q >> 5, wi = q & 31, key = 8 * (sub >> 2) + (wi >> 2), ch = (sub & 3) * 4 + (wi & 3);
        vso[i] = key * (int)d.vs + 8 * ch; }
#define FA_DMA(t, kslot, vslot) do { const bf16* kt_ = d.K + (long)(64 * (t)) * d.ks; const bf16* vt_ = d.V + (long)(64 * (t)) * d.vs; const bf16* pt_ = (DQK == 192) ? d.KPE + (long)(64 * (t)) * d.kps : kt_; \
    _Pragma("unroll") for (int i = 0; i < KINST; ++i) __builtin_amdgcn_global_load_lds((const unsigned*)((kpe_[i] ? pt_ : kt_) + kso[i]), (LAS unsigned*)(lds + (kslot) * KT + 1024 * (KINST * w + i)), 16, 0, 0); \
    _Pragma("unroll") for (int i = 0; i < 2; ++i) __builtin_amdgcn_global_load_lds((const unsigned*)(vt_ + vso[i]), (LAS unsigned*)(lds + LDS_V + (vslot) * VT + 1024 * (2 * w + i)), 16, 0, 0); } while (0)
    int koff[NKO];
#pragma unroll
    for (int j = 0; j < NKO; ++j) koff[j] = (DQK == 192) ? (r * KROW + 16 * ((2 * j + hi) ^ ((r >> 1) & 7))) : (r * KROW + 16 * ((2 * j + hi) ^ (r & 15)));
    const int vfo = LDS_V + (4 * hi + ((lane & 15) >> 2)) * 64 + ((lane >> 4) & 1) * 32 + (lane & 3) * 8;
#define FA_KADDR(kslot, kb, ks) (lds + (kslot) * KT + koff[(DQK == 192) ? ((ks) & 3) : (ks)] + ((DQK == 192) ? 128 * ((ks) >> 2) : 0) + (kb) * 32 * KROW)

    constexpr int NI = KINST + 2;
#define FA_WAIT_NI() do { if constexpr (NI == 5) asm volatile("s_waitcnt vmcnt(5)" ::: "memory"); else asm volatile("s_waitcnt vmcnt(4)" ::: "memory"); } while (0)
    FA_DMA(d.t_lo, 0, 0);
    if (d.t_lo + 1 < d.t_hi) { FA_DMA(d.t_lo + 1, 1, 1); FA_WAIT_NI(); } else { asm volatile("s_waitcnt vmcnt(0)" ::: "memory"); }
    __builtin_amdgcn_s_barrier();
    int slot = 0;
#pragma unroll 1
    for (int t = d.t_lo; t < d.t_hi; ++t) {
        const int s2n = (slot >= 1) ? slot - 1 : 2;
        const bool pre = t + 2 < d.t_hi;
        if (pre) FA_DMA(t + 2, s2n, s2n);
        const bool active = (64 * t <= qw + 31) && (64 * t + 63 >= qw - d.W);
        if (active) {
            const unsigned vba = (unsigned)(unsigned long)(lds + vfo + slot * VT);
            f32x16 p0, p1;
#pragma unroll
            for (int i = 0; i < 16; ++i) { p0[i] = 0.f; p1[i] = 0.f; }
            constexpr int PF = 4;
            bf16x8 kf0[PF], kf1[PF];
#pragma unroll
            for (int i = 0; i < PF; ++i) { kf0[i] = *(const LAS bf16x8*)FA_KADDR(slot, 0, i); kf1[i] = *(const LAS bf16x8*)FA_KADDR(slot, 1, i); }
            FA_SB();
#pragma unroll
            for (int ks = 0; ks < NKS; ++ks) {
                const bf16x8 a0 = kf0[ks % PF], a1 = kf1[ks % PF];
                p0 = FA_MFMA(a0, qr[ks], p0); p1 = FA_MFMA(a1, qr[ks], p1);
                if (ks + PF < NKS) { kf0[ks % PF] = *(const LAS bf16x8*)FA_KADDR(slot, 0, ks + PF); kf1[ks % PF] = *(const LAS bf16x8*)FA_KADDR(slot, 1, ks + PF); }
                FA_SB();
            }
            s16x4 vlo[2][4], vhh[2][4];
            vtr8_issue<0>(vba, vlo[0], vhh[0]);
            const bool full = (64 * t + 63 <= qw) && (64 * t >= qw + 31 - d.W) && (d.slope2 == 0.f);
            if (!full) {
                const int dist0 = myq - 64 * t - 4 * hi;
#pragma unroll
                for (int i = 0; i < 16; ++i) { const int d0 = dist0 - ((i & 3) + 8 * (i >> 2)), d1 = d0 - 32;
                    p0[i] = ((unsigned)d0 <= (unsigned)d.W) ? __builtin_fmaf(-d.slope2, (float)d0, p0[i]) : NEG;
                    p1[i] = ((unsigned)d1 <= (unsigned)d.W) ? __builtin_fmaf(-d.slope2, (float)d1, p1[i]) : NEG; }
            }
            float mx = fmaxf(p0[0], p1[0]);
#pragma unroll
            for (int i = 1; i < 16; ++i) mx = fmaxf(mx, fmaxf(p0[i], p1[i]));
            mx = fmaxf(mx, __shfl_xor(mx, 32));
            const float mn = fmaxf(m, mx), corr = __builtin_amdgcn_exp2f(m - mn); const bool grew = __any(mn > m); m = mn;
            float ls = 0.f;
#pragma unroll
            for (int i = 0; i < 16; ++i) { p0[i] = __builtin_amdgcn_exp2f(p0[i] - mn); p1[i] = __builtin_amdgcn_exp2f(p1[i] - mn); ls += p0[i] + p1[i]; }
            l = l * corr + ls;
            if (grew) {
#pragma unroll
                for (int db = 0; db < 4; ++db)
#pragma unroll
                    for (int i = 0; i < 16; ++i) o[db][i] *= corr;
            }
#pragma unroll
            for (int g4 = 0; g4 < 4; ++g4) {
                v4u pkw;
                if (g4 == 0) { pkw.x = pk2(p0[0], p0[1]); pkw.y = pk2(p0[2], p0[3]); pkw.z = pk2(p0[4], p0[5]); pkw.w = pk2(p0[6], p0[7]); }
                if (g4 == 1) { pkw.x = pk2(p0[8], p0[9]); pkw.y = pk2(p0[10], p0[11]); pkw.z = pk2(p0[12], p0[13]); pkw.w = pk2(p0[14], p0[15]); }
                if (g4 == 2) { pkw.x = pk2(p1[0], p1[1]); pkw.y = pk2(p1[2], p1[3]); pkw.z = pk2(p1[4], p1[5]); pkw.w = pk2(p1[6], p1[7]); }
                if (g4 == 3) { pkw.x = pk2(p1[8], p1[9]); pkw.y = pk2(p1[10], p1[11]); pkw.z = pk2(p1[12], p1[13]); pkw.w = pk2(p1[14], p1[15]); }
                const bf16x8 pf = __builtin_bit_cast(bf16x8, pkw);
                vtr8_wait(vlo[g4 & 1], vhh[g4 & 1]);
                if (g4 == 0) vtr8_issue<4096>(vba, vlo[1], vhh[1]);
                if (g4 == 1) vtr8_issue<8192>(vba, vlo[0], vhh[0]);
                if (g4 == 2) vtr8_issue<12288>(vba, vlo[1], vhh[1]);
#pragma unroll
                for (int db = 0; db < 4; ++db) {
                    const bf16x8 vf = __builtin_shufflevector(vlo[g4 & 1][db], vhh[g4 & 1][db], 0, 1, 2, 3, 4, 5, 6, 7);
                    o[db] = FA_MFMA(vf, pf, o[db]);
                }
            }
        }
        if (pre) FA_WAIT_NI(); else asm volatile("s_waitcnt vmcnt(0)" ::: "memory");
        asm volatile("s_waitcnt lgkmcnt(0)" ::: "memory");
        __builtin_amdgcn_s_barrier();
        slot = (slot == 2) ? 0 : slot + 1;
    }
    int tid_e = threadIdx.x; asm volatile("" : "+v"(tid_e));
    const int r_e = tid_e & 31, hi_e = (tid_e >> 5) & 1;
    l += __shfl_xor(l, 32);
    const float inv = 1.0f / l;
    bf16* op = d.O + (long)(32 * w + r_e) * d.os + 4 * hi_e;
#pragma unroll
    for (int db = 0; db < 4; ++db)
#pragma unroll
        for (int g = 0; g < 4; ++g) { v2u wv; wv.x = pk2(o[db][4 * g] * inv, o[db][4 * g + 1] * inv); wv.y = pk2(o[db][4 * g + 2] * inv, o[db][4 * g + 3] * inv); *(v2u*)(op + 32 * db + 8 * g) = wv; }
    if (HAS_LSE) { if (hi_e == 0) d.LSE[(long)(32 * w + r_e) * d.lses] = m + __builtin_amdgcn_logf(l); }
#undef FA_DMA
#undef FA_WAIT_NI
#undef FA_KADDR
}
}
__global__ void __launch_bounds__(NWAVES * 64, 2) mega_fwd(Args args) {
    extern __shared__ __attribute__((aligned(16))) unsigned char lds[];
    cg::grid_group grid = cg::this_grid();
    LAS unsigned char* ldsp = (LAS unsigned char*)lds;
    const int wave = __builtin_amdgcn_readfirstlane(threadIdx.x >> 6);
    const int G = gridDim.x, bx = blockIdx.x;
    const int gw = bx * NWAVES + wave, NGW = G * NWAVES;
    unsigned char* ws = args.ws;
    const int lo = args.ph_lo, hi = args.ph_hi;
    int ph = 0;
    if (lo < 0) grid.sync();
#define IN_PH (ph >= lo && ph < hi)
#define PHV int tid = threadIdx.x; asm volatile("" : "+v"(tid)); const int lane = tid & 63; (void)lane;
#define SEAM do { if (ph >= lo && ph + 1 < hi) xcd_barrier(bar); ++ph; } while (0)

    if (threadIdx.x < 64) ((LAS unsigned*)(ldsp + LDS_CTL))[threadIdx.x] = 0u;
    __syncthreads();
    XcdBarrier bar = xcd_barrier_post((unsigned*)ws, (volatile LAS unsigned*)(ldsp + LDS_CTL));
    bf16* XN = (bf16*)(ws + WS_XN); bf16* HB = (bf16*)(ws + WS_H);
    float* xout = args.out;

#ifndef REP_CONV
#define REP_CONV 1
#endif
#ifndef REP_MLA
#define REP_MLA 1
#endif
#ifndef REP_DIL
#define REP_DIL 1
#endif
#ifndef REP_FFNIN
#define REP_FFNIN 1
#endif
#ifndef REP_RMS
#define REP_RMS 1
#endif
#ifndef REP_UQ
#define REP_UQ 1
#endif
#ifndef REP_LAT
#define REP_LAT 1
#endif
#ifndef REP_QKV
#define REP_QKV 1
#endif
#ifndef REP_FFNOUT0
#define REP_FFNOUT0 1
#endif
#ifndef EXTRA_SYNC
#define EXTRA_SYNC 0
#endif
    if (IN_PH) for (int rep_ = 0; rep_ < REP_CONV; ++rep_) { PHV
        LAS float* scr = (LAS float*)(ldsp + wave * 16384);
#pragma unroll 1
        for (int lf = 0; lf < 4; ++lf) {
            const int layer = lf >> 1, f = lf & 1;
            const float* wi = (f ? args.in[I_F2WI] : args.in[I_F1WI]) + (size_t)layer * D * 2 * FF;
            const float* wo = (f ? args.in[I_F2WO] : args.in[I_F1WO]) + (size_t)layer * FF * D;
            conv_matrix<1>(wi, D, 2 * FF, (bf16*)(ws + WS_FFN + lf * FFN_STRIDE), scr, gw, NGW, lane);
            conv_matrix<0>(wo, FF, D, (bf16*)(ws + WS_FFN + lf * FFN_STRIDE + FFN_WOUT), scr, gw, NGW, lane);
        }
        conv_matrix<0>(args.in[I_MDOWN], D, NLAT, (bf16*)(ws + WS_DOWN), scr, gw, NGW, lane);
        conv_matrix<0>(args.in[I_MUQ], QL, NQ, (bf16*)(ws + WS_UQ), scr, gw, NGW, lane);
        conv_matrix<0>(args.in[I_MUKV], KVL, MH * 256, (bf16*)(ws + WS_UKV), scr, gw, NGW, lane);
        conv_matrix<0>(args.in[I_MWO], MH * VD, D, (bf16*)(ws + WS_MWO), scr, gw, NGW, lane);
        conv_matrix<0>(args.in[I_DQKV], D, NQKV, (bf16*)(ws + WS_DQKV), scr, gw, NGW, lane);
        conv_matrix<0>(args.in[I_DWO], DO, D, (bf16*)(ws + WS_DWO), scr, gw, NGW, lane);
        for (int m = gw; m < M; m += NGW) rms_row_to_bf16(args.in[I_X] + (size_t)m * D, args.in[I_F1N], XN + (size_t)m * D, lane);
        { const int gt = bx * (NWAVES * 64) + tid, NT = G * NWAVES * 64; const v4u z = {0u, 0u, 0u, 0u};
          v4u* p1 = (v4u*)((bf16*)(ws + WS_DOWN) + (size_t)NLAT * D); const int n1 = (NLATP - NLAT) * D / 8;
          for (int i = gt; i < n1; i += NT) p1[i] = z;
        }
    }
    SEAM;

#pragma unroll 1
    for (int layer = 0; layer < 2; ++layer) {
#pragma unroll 1
        for (int f = 0; f < 2; ++f) {
            const int lf = layer * 2 + f;
            const float* xin = (lf == 0) ? args.in[I_X] : xout;
            if (lf != 0) {
            if (IN_PH) { PHV const float* g = (f ? args.in[I_F2N] : args.in[I_F1N]) + layer * D;
                for (int rep_ = 0; rep_ < REP_RMS; ++rep_) for (int m = gw; m < M; m += NGW) rms_row_to_bf16(xin + (size_t)m * D, g, XN + (size_t)m * D, lane); }
            SEAM;
            }
            if (IN_PH) for (int rep_ = 0; rep_ < REP_FFNIN; ++rep_) { PHV pg8::Gemm g{XN, (const bf16*)(ws + WS_FFN + lf * FFN_STRIDE), M, 2 * FF, D}; pg8::StaticOrder S; S.init(M, 2 * FF, G, bx);
                pg8::EpiSwiGLU E{HB, FF}; pg8::gemm_phase<pg8::EpiSwiGLU, pg8::StaticOrder, true, true>(ldsp, g, S, E); }
            SEAM;
            if (IN_PH) for (int rep_ = 0; rep_ < ((lf == 0) ? REP_FFNOUT0 : 1); ++rep_) { PHV pg8::Gemm g{HB, (const bf16*)(ws + WS_FFN + lf * FFN_STRIDE + FFN_WOUT), M, D, FF}; pg8::StaticOrder S; S.init(M, D, G, bx);
                pg8::EpiRes E{xin, xout, D, 0.5f}; pg8::gemm_phase<pg8::EpiRes, pg8::StaticOrder, true, true>(ldsp, g, S, E); }
            SEAM;
            if (f == 0) {
                if (IN_PH) { PHV const float* g = args.in[I_MIXN] + layer * D;
                    for (int m = gw; m < M; m += NGW) rms_row_to_bf16(xout + (size_t)m * D, g, XN + (size_t)m * D, lane); }
                SEAM;
                if (layer == 0) {
                    float* LAT = (float*)(ws + WS_LAT); bf16* CQ = (bf16*)(ws + WS_CQ); bf16* CKV = (bf16*)(ws + WS_CKV); bf16* QB = (bf16*)(ws + WS_Q); bf16* KVB = (bf16*)(ws + WS_KV); bf16* KPE = (bf16*)(ws + WS_KPE); bf16* MO = (bf16*)(ws + WS_MO);
                    if (IN_PH) for (int rep_ = 0; rep_ < REP_LAT; ++rep_) { PHV pg8::Gemm g{XN, (const bf16*)(ws + WS_DOWN), M, NLATP, D}; pg8::StaticOrder S; S.init(M, NLATP, G, bx);
                        pg8::EpiF32 E{LAT, NLATP}; pg8::gemm_phase<pg8::EpiF32, pg8::StaticOrder, true, true>(ldsp, g, S, E); }
                    SEAM;
                    if (IN_PH) { PHV
                        for (int m = gw; m < M; m += NGW) {
#pragma unroll
                            for (int p = 0; p < 2; ++p) {
                                const f32x4* r = (const f32x4*)(LAT + (size_t)m * NLATP + 512 * p) + lane; const f32x4 v0 = r[0], v1 = r[64];
                                float s = (v0.x * v0.x + v0.y * v0.y) + (v0.z * v0.z + v0.w * v0.w) + (v1.x * v1.x + v1.y * v1.y) + (v1.z * v1.z + v1.w * v1.w);
                                const float rs = 1.0f / sqrtf(wave_sum(s) * (1.f / 512.f) + EPS);
                                const f32x4* gr = (const f32x4*)(p ? args.in[I_MGCKV] : args.in[I_MGCQ]) + lane; const f32x4 g0 = gr[0], g1 = gr[64];
                                v2u* o8 = (v2u*)((p ? CKV : CQ) + (size_t)m * 512) + lane;
                                v2u w; w.x = pk2(v0.x * rs * g0.x, v0.y * rs * g0.y); w.y = pk2(v0.z * rs * g0.z, v0.w * rs * g0.w); o8[0] = w;
                                w.x = pk2(v1.x * rs * g1.x, v1.y * rs * g1.y); w.y = pk2(v1.z * rs * g1.z, v1.w * rs * g1.w); o8[64] = w;
                            }
                        }
                    }
                    SEAM;
                    if (IN_PH) for (int rep_ = 0; rep_ < REP_UQ; ++rep_) { PHV
                        { static_assert(WS_CKV == WS_CQ + (size_t)M * QL * 2 && WS_UKV == WS_UQ + (size_t)NQ * QL * 2 && QL == KVL, "c_q | c_kv and Wuq^T | Wukv^T must be contiguous for the combined stream");
                          pg8::Gemm g{CQ, (const bf16*)(ws + WS_UQ), 2 * M, NQ + NKV, QL}; pg8::QKVOrder S; S.init(M, NQ, NKV, G, bx);
                          pg8::EpiQKV2 E{QB, KVB, NQ, NKV, NQ / 256, M / 256}; pg8::gemm_phase<pg8::EpiQKV2, pg8::QKVOrder, true, true>(ldsp, g, S, E); }
                    }
                    SEAM;
                    if (IN_PH) { PHV
                        const int grp = lane >> 5, p = lane & 31; const bool act = p < 24, pe1 = (p >= 16 && p < 20), pe2 = (p >= 20 && p < 24), nope = p < 16;
                        const float QS = 0.07216878364870322f * LOG2E;
                        float gq[8], gk[8];
#pragma unroll
                        for (int e = 0; e < 8; ++e) { gq[e] = 0.f; gk[e] = 0.f; }
                        if (act) { const f32x4 a0 = ((const f32x4*)args.in[I_MGQN])[2 * p], a1 = ((const f32x4*)args.in[I_MGQN])[2 * p + 1], b0 = ((const f32x4*)args.in[I_MGKN])[2 * p], b1 = ((const f32x4*)args.in[I_MGKN])[2 * p + 1];
                            gq[0] = a0.x; gq[1] = a0.y; gq[2] = a0.z; gq[3] = a0.w; gq[4] = a1.x; gq[5] = a1.y; gq[6] = a1.z; gq[7] = a1.w;
                            gk[0] = b0.x; gk[1] = b0.y; gk[2] = b0.z; gk[3] = b0.w; gk[4] = b1.x; gk[5] = b1.y; gk[6] = b1.z; gk[7] = b1.w; }
                        for (int m = gw; m < M; m += NGW) {
                            const int pos = m % SEQ;
                            float cs[8], sn[8], kpe[8];
#pragma unroll
                            for (int j = 0; j < 8; ++j) { cs[j] = 1.f; sn[j] = 0.f; kpe[j] = 0.f; }
                            if (pe1 || pe2) {
#pragma unroll
                                for (int j = 0; j < 8; ++j) { const int i = 8 * (p & 3) + j; const float inv = exp2f(-(float)i * (13.287712379549449f / 32.0f)); const float ang = (float)pos * inv; cs[j] = cosf(ang); sn[j] = sinf(ang); }
                                const f32x4 k0 = ((const f32x4*)(LAT + (size_t)m * NLATP + 1024))[2 * (p - 16)], k1 = ((const f32x4*)(LAT + (size_t)m * NLATP + 1024))[2 * (p - 16) + 1];
                                kpe[0] = k0.x; kpe[1] = k0.y; kpe[2] = k0.z; kpe[3] = k0.w; kpe[4] = k1.x; kpe[5] = k1.y; kpe[6] = k1.z; kpe[7] = k1.w;
                            }
                            v4u rq[8], rk[8];
#pragma unroll
                            for (int it = 0; it < 8; ++it) { const int h = 2 * it + grp; rq[it] = (v4u){0u, 0u, 0u, 0u}; rk[it] = (v4u){0u, 0u, 0u, 0u};
                                if (act) rq[it] = *((const v4u*)(QB + (size_t)m * NQ + h * QKD) + p);
                                if (nope) rk[it] = *((const v4u*)(KVB + (size_t)m * NKV + h * KVROW) + p); }
#pragma unroll
                            for (int it = 0; it < 8; ++it) { const int h = 2 * it + grp;
                                float x[8]; unpack8(rq[it], x);
                                float ss = 0.f;
#pragma unroll
                                for (int e = 0; e < 8; ++e) ss += x[e] * x[e];
                                ss += __shfl_xor(ss, 1); ss += __shfl_xor(ss, 2); ss += __shfl_xor(ss, 4); ss += __shfl_xor(ss, 8); ss += __shfl_xor(ss, 16);
                                float rs = 1.0f / sqrtf(ss * (1.f / 192.f) + EPS);
                                float y[8];
#pragma unroll
                                for (int e = 0; e < 8; ++e) { y[e] = x[e] * rs * gq[e]; const float oth = __shfl_xor(y[e], 4); if (pe1) y[e] = y[e] * cs[e] - oth * sn[e]; else if (pe2) y[e] = oth * sn[e] + y[e] * cs[e]; y[e] *= QS; }
                                if (act) { v4u wv; wv.x = pk2(y[0], y[1]); wv.y = pk2(y[2], y[3]); wv.z = pk2(y[4], y[5]); wv.w = pk2(y[6], y[7]); *((v4u*)(QB + (size_t)m * NQ + h * QKD) + p) = wv; }
                                unpack8(rk[it], x);
                                if (!nope) {
#pragma unroll
                                    for (int e = 0; e < 8; ++e) x[e] = kpe[e];
                                }
                                ss = 0.f;
#pragma unroll
                                for (int e = 0; e < 8; ++e) ss += x[e] * x[e];
                                ss += __shfl_xor(ss, 1); ss += __shfl_xor(ss, 2); ss += __shfl_xor(ss, 4); ss += __shfl_xor(ss, 8); ss += __shfl_xor(ss, 16);
                                rs = 1.0f / sqrtf(ss * (1.f / 192.f) + EPS);
#pragma unroll
                                for (int e = 0; e < 8; ++e) { y[e] = x[e] * rs * gk[e]; const float oth = __shfl_xor(y[e], 4); if (pe1) y[e] = y[e] * cs[e] - oth * sn[e]; else if (pe2) y[e] = oth * sn[e] + y[e] * cs[e]; }
                                if (act) { v4u wv; wv.x = pk2(y[0], y[1]); wv.y = pk2(y[2], y[3]); wv.z = pk2(y[4], y[5]); wv.w = pk2(y[6], y[7]); if (nope) *((v4u*)(KVB + (size_t)m * NKV + h * KVROW) + p) = wv; else *((v4u*)(KPE + (size_t)m * (MH * ROPE) + h * ROPE) + (p - 16)) = wv; }
                            }
                        }
                    }
                    SEAM;
                    if (IN_PH) { PHV
#ifdef NAIVE_MLA
#pragma unroll 1
                        for (int u = bx; u < BATCH * MH * 32; u += G) { const int qt = 31 - u / (BATCH * MH), bh = u % (BATCH * MH); mla_attn_naive_unit(QB, KVB, MO, bh / MH, bh % MH, qt, tid); }
#else
                        const int vcu = (G % 8 == 0) ? (bx % 8) * (G / 8) + bx / 8 : bx;
#pragma unroll 1
                        for (int u = vcu; u < REP_MLA * BATCH * MH * 16; u += G) {
                            const int v = u & 255, i = (u >> 8) & 3, bh = v >> 2, s = v & 3, b = bh / MH, h = bh % MH;
                            const int qb = (i == 0) ? s : (i == 1) ? 7 - s : (i == 2) ? 8 + s : 15 - s;
                            fa::Desc dsc;
                            dsc.Q = QB + (size_t)(b * SEQ + 256 * qb) * NQ + h * QKD; dsc.qs = NQ;
                            dsc.K = KVB + (size_t)(b * SEQ) * NKV + h * KVROW; dsc.ks = NKV;
                            dsc.V = dsc.K + NOPE; dsc.vs = NKV; dsc.KPE = KPE + (size_t)(b * SEQ) * (MH * ROPE) + h * ROPE; dsc.kps = MH * ROPE;
                            dsc.O = MO + (size_t)(b * SEQ + 256 * qb) * D + h * VD; dsc.os = D;
                            dsc.LSE = nullptr; dsc.lses = 0;
                            dsc.Q0 = 256 * qb; dsc.t_lo = 0; dsc.t_hi = 4 * qb + 4; dsc.W = 1 << 30; dsc.slope2 = 0.f;
                            fa::unit<QKD, false>(ldsp, dsc);
                        }
#endif
                    }
                    SEAM;
                    if (IN_PH) { PHV pg8::Gemm g{MO, (const bf16*)(ws + WS_MWO), M, D, MH * VD}; pg8::StaticOrder S; S.init(M, D, G, bx);
                        pg8::EpiRes E{xout, xout, D, 1.0f}; pg8::gemm_phase<pg8::EpiRes, pg8::StaticOrder, true, true>(ldsp, g, S, E); }
                    SEAM;
                } else {
                    bf16* QKV = (bf16*)(ws + WS_QKV); bf16* DOB = (bf16*)(ws + WS_DOUT);
                    if (IN_PH) for (int rep_ = 0; rep_ < REP_QKV; ++rep_) { PHV pg8::Gemm g{XN, (const bf16*)(ws + WS_DQKV), M, NQKV, D}; pg8::StaticOrder S; S.init(M, NQKV, G, bx);
                        pg8::EpiQKNorm E{QKV, NQKV, args.in[I_DGQN], args.in[I_DGKN], (PG8_LAS float*)(ldsp + LDS_PS), 0.08838834764831845f * LOG2E};
                        pg8::gemm_phase<pg8::EpiQKNorm, pg8::StaticOrder, true, true>(ldsp, g, S, E); }
                    SEAM;
#ifdef NAIVE_DIL
                    if (IN_PH) { PHV
#pragma unroll 1
                        for (int u = bx; u < (M / 128) * DH; u += G) dil_attn_naive_unit(QKV, DOB, u / DH, u % DH, tid);
                    }
                    SEAM;
#else
                    bf16* OG01 = (bf16*)(ws + WS_XN); bf16* OG2 = (bf16*)(ws + WS_DOUT + 32 * MiB); float* LSEB = (float*)(ws + WS_DOUT + 64 * MiB);
                    if (IN_PH) { PHV
#pragma unroll 1
                        for (int u0 = bx; u0 < REP_DIL * DG * BATCH * DH * 16; u0 += G) { const int u = u0 % (DG * BATCH * DH * 16);
                            const int g = u >> 9, rem = u & 511, b = rem >> 7, h = (rem >> 4) & 7, k = rem & 15;
                            const int sh = 2 * g, dil = 1 << sh;
                            const int blk = (g == 0) ? k : (g == 1) ? (k & 3) : 0, res = (g == 0) ? 0 : (g == 1) ? (k >> 2) : k;
                            const int Q0 = 256 * blk; const size_t tok0 = (size_t)b * SEQ + res;
                            fa::Desc dsc;
                            dsc.Q = QKV + (tok0 + (size_t)dil * Q0) * NQKV + g * DO + h * DHD; dsc.qs = (long)dil * NQKV;
                            dsc.K = QKV + tok0 * NQKV + 3072 + g * DO + h * DHD; dsc.ks = (long)dil * NQKV;
                            dsc.V = dsc.K + 3072; dsc.vs = (long)dil * NQKV; dsc.KPE = nullptr; dsc.kps = 0;
                            bf16* og = (g < 2) ? OG01 + (size_t)g * M * DO : OG2;
                            dsc.O = og + (tok0 + (size_t)dil * Q0) * DO + h * DHD; dsc.os = (long)dil * DO;
                            dsc.LSE = LSEB + (size_t)g * M * DH + (tok0 + (size_t)dil * Q0) * DH + h; dsc.lses = dil * DH;
                            dsc.Q0 = Q0; dsc.t_lo = (Q0 >= 128) ? (Q0 - 128) / 64 : 0; dsc.t_hi = (Q0 + 256) / 64; dsc.W = 128;
                            dsc.slope2 = __builtin_amdgcn_exp2f(-(float)(g * DH + h + 1) * (1.0f / 3.0f)) * (float)dil * LOG2E;
                            fa::unit<DHD, true>(ldsp, dsc);
                        }
                    }
                    SEAM;
                    if (IN_PH) { PHV
                        for (int m = gw; m < M; m += NGW) {
                            const int h = lane >> 3;
                            const float l0 = LSEB[(size_t)m * DH + h], l1 = LSEB[(size_t)(M + m) * DH + h], l2 = LSEB[(size_t)(2 * M + m) * DH + h];
                            const float mx = fmaxf(l0, fmaxf(l1, l2));
                            float w0 = __builtin_amdgcn_exp2f(l0 - mx), w1 = __builtin_amdgcn_exp2f(l1 - mx), w2 = __builtin_amdgcn_exp2f(l2 - mx);
                            const float rs = 1.0f / (w0 + w1 + w2); w0 *= rs; w1 *= rs; w2 *= rs;
                            const v4u* a0 = (const v4u*)(OG01 + (size_t)m * DO) + 2 * lane; const v4u* a1 = (const v4u*)(OG01 + (size_t)(M + m) * DO) + 2 * lane; const v4u* a2 = (const v4u*)(OG2 + (size_t)m * DO) + 2 * lane;
                            v4u* op = (v4u*)(DOB + (size_t)m * DO) + 2 * lane;
#pragma unroll
                            for (int c = 0; c < 2; ++c) { float x0[8], x1[8], x2[8]; unpack8(a0[c], x0); unpack8(a1[c], x1); unpack8(a2[c], x2);
                                float y[8];
#pragma unroll
                                for (int e = 0; e < 8; ++e) y[e] = w0 * x0[e] + w1 * x1[e] + w2 * x2[e];
                                v4u wv; wv.x = pk2(y[0], y[1]); wv.y = pk2(y[2], y[3]); wv.z = pk2(y[4], y[5]); wv.w = pk2(y[6], y[7]); op[c] = wv; }
                        }
                    }
                    SEAM;
#endif
                    if (IN_PH) { PHV pg8::Gemm g{DOB, (const bf16*)(ws + WS_DWO), M, D, DO}; pg8::StaticOrder S; S.init(M, D, G, bx);
                        pg8::EpiRes E{xout, xout, D, 1.0f}; pg8::gemm_phase<pg8::EpiRes, pg8::StaticOrder, true, true>(ldsp, g, S, E); }
                    SEAM;
                }
            }
        }
    }
    for (int es_ = 0; es_ < EXTRA_SYNC; ++es_) xcd_barrier(bar);
#undef IN_PH
#undef SEAM
}

extern "C" void kernel_launch(void* const* d_in, const int* in_sizes, int n_in, void* d_out, int out_size, void* d_ws, size_t ws_size, hipStream_t stream) {
    static int grid = 0;
    if (grid == 0) {
        if (n_in != 20 || out_size != M * D || ws_size < WS_END) { fprintf(stderr, "kernel_launch: unexpected sizes n_in %d out %d ws %zu (need %zu)\n", n_in, out_size, ws_size, (size_t)WS_END); grid = -1; return; }
        int dev = 0, cus = 0, per_cu = 0;
        hipGetDevice(&dev); hipDeviceGetAttribute(&cus, hipDeviceAttributeMultiprocessorCount, dev);
        if (hipFuncSetAttribute((const void*)mega_fwd, hipFuncAttributeMaxDynamicSharedMemorySize, LDS_BYTES) != hipSuccess) { fprintf(stderr, "kernel_launch: hipFuncSetAttribute failed\n"); grid = -1; return; }
        if (hipOccupancyMaxActiveBlocksPerMultiprocessor(&per_cu, (const void*)mega_fwd, NWAVES * 64, LDS_BYTES) != hipSuccess || per_cu < 1) { fprintf(stderr, "kernel_launch: occupancy query says %d\n", per_cu); per_cu = 1; }
        (void)hipGetLastError();
        grid = cus * 1;
        fprintf(stderr, "kernel_launch: cus %d per_cu %d grid %d\n", cus, per_cu, grid);
    }
    if (grid < 0) return;
    if (hipMemsetAsync(d_ws, 0, 16384, stream) != hipSuccess) { fprintf(stderr, "kernel_launch: memset failed\n"); return; }
    Args a{};
    for (int i = 0; i < 20; ++i) a.in[i] = (const float*)d_in[i];
    a.out = (float*)d_out; a.ws = (unsigned char*)d_ws; a.ph_lo = 0; a.ph_hi = 1000;
    void* kargs[] = {&a};
    hipError_t e = hipLaunchCooperativeKernel((const void*)mega_fwd, dim3(grid), dim3(NWAVES * 64), kargs, LDS_BYTES, stream);
    if (e != hipSuccess) fprintf(stderr, "kernel_launch: cooperative launch failed: %s (grid %d)\n", hipGetErrorString(e), grid);
}
```

```cpp
#include <hip/hip_runtime.h>
#include <hip/hip_cooperative_groups.h>
#include <cstdio>
#include <cstdint>
namespace cg = cooperative_groups;

namespace pg8 {
#define PG8_LAS __attribute__((address_space(3)))
typedef unsigned short bf16_t;
typedef short bf16x8 __attribute__((ext_vector_type(8)));
typedef float f32x4 __attribute__((ext_vector_type(4)));
typedef unsigned u32x4 __attribute__((ext_vector_type(4)));
constexpr int BM = 256, BK = 64, HALF = 128, HTB = HALF * BK * 2  , STAGE_BYTES = 8 * HTB, NXCD = 8, WGM = 8;

__host__ __device__ __forceinline__ int lds_byte(int r, int c) { const int st = (r >> 4) * 2 + (c >> 5), rr = r & 15, cc = c & 31, ob = rr * 64 + cc * 2; return st * 1024 + (ob ^ (((ob >> 9) & 1) << 5)); }
__host__ __device__ __forceinline__ void stage_rc(int b, int& R, int& C) { const int st = b / 1024, sb = b % 1024, swz = sb ^ (((sb >> 9) & 1) << 5); R = (st >> 1) * 16 + swz / 64; C = (st & 1) * 32 + (swz % 64) / 2; }
__host__ __device__ __forceinline__ int perm32(int rho) { const int n = rho >> 4, i = rho & 15; return 8 * (i >> 2) + 4 * n + (i & 3); }

struct Unit { int pm, pn; };
struct Gemm { const bf16_t* A; const bf16_t* Bt; int M, N, K; };

struct StaticOrder {
    int nM, nN, nwg, G, c;
    __host__ __device__ void init(int M, int N, int G_, int c_) { nM = M / BM; nN = N / BM; nwg = nM * nN; G = G_; c = c_; }
    __host__ __device__ bool next(int i, Unit& u) const {
        const long L = (long)i * G + c; if (L >= nwg) return false;
        int wgid = (int)L; { const int q = nwg / NXCD, r = nwg % NXCD, xcd = wgid % NXCD, off = wgid / NXCD; wgid = (xcd < r ? xcd * (q + 1) : r * (q + 1) + (xcd - r) * q) + off; }
        const int nig = WGM * nN, gid = wgid / nig, fm = gid * WGM, gsz = (nM - fm) < WGM ? (nM - fm) : WGM;
        u.pm = fm + ((wgid % nig) % gsz); u.pn = (wgid % nig) / gsz; return true;
    }
    __device__ __forceinline__ void a_ready(const Unit&) const {}
    __device__ __forceinline__ void done(const Unit&) const {}
};
struct QKVOrder {
    StaticOrder sq, skv; int G, c, nqu;
    __host__ __device__ void init(int M, int Nq, int Nkv, int G_, int c_) { sq.init(M, Nq, 1, 0); skv.init(M, Nkv, 1, 0); G = G_; c = c_; nqu = sq.nwg; }
    __host__ __device__ bool next(int i, Unit& u) const {
        const int L = i * G + c;
        if (L < nqu) return sq.next(L, u);
        if (!skv.next(L - nqu, u)) return false;
        u.pm += sq.nM; u.pn += sq.nN; return true;
    }
    __device__ __forceinline__ void a_ready(const Unit&) const {}
    __device__ __forceinline__ void done(const Unit&) const {}
};

__device__ __forceinline__ unsigned cvt_pk_bf16(float lo, float hi) { unsigned r; asm volatile("v_cvt_pk_bf16_f32 %0, %1, %2" : "=v"(r) : "v"(lo), "v"(hi)); return r; }

struct EpiBf16 {
    static constexpr bool PERM = true, AFTER_DRAIN = false;
    bf16_t* O; int ldc;
    __device__ __forceinline__ void operator()(const f32x4 (&acc)[2][2][4][2], const Unit& u, int wr, int wc, int fr, int fq) const {
        const int row0 = u.pm * BM + wr * 64 + fr; const int col0 = u.pn * BM + wc * 32 + 8 * fq;
#pragma unroll
        for (int ai = 0; ai < 2; ++ai)
#pragma unroll
            for (int m = 0; m < 4; ++m) { bf16_t* rowp = O + (size_t)(row0 + ai * HALF + m * 16) * ldc + col0;
#pragma unroll
                for (int bj = 0; bj < 2; ++bj) { const f32x4 v0 = acc[ai][bj][m][0], v1 = acc[ai][bj][m][1];
                    u32x4 w; w.x = cvt_pk_bf16(v0[0], v0[1]); w.y = cvt_pk_bf16(v0[2], v0[3]); w.z = cvt_pk_bf16(v1[0], v1[1]); w.w = cvt_pk_bf16(v1[2], v1[3]);
                    *(u32x4*)(rowp + bj * HALF) = w; } }
    }
};

__device__ __forceinline__ float silu_mul(float g, float u) { return g * __builtin_amdgcn_rcpf(1.0f + __builtin_amdgcn_exp2f(-1.4426950408889634f * g)) * u; }
struct EpiSwiGLU {
    static constexpr bool PERM = true, AFTER_DRAIN = false;
    bf16_t* H; int ldc;
    __device__ __forceinline__ void operator()(const f32x4 (&acc)[2][2][4][2], const Unit& u, int wr, int wc, int fr, int fq) const {
        const int row0 = u.pm * BM + wr * 64 + fr; const int col0 = u.pn * HALF + wc * 32 + 8 * fq;
#pragma unroll
        for (int ai = 0; ai < 2; ++ai)
#pragma unroll
            for (int m = 0; m < 4; ++m) { bf16_t* rowp = H + (size_t)(row0 + ai * HALF + m * 16) * ldc + col0;
                const f32x4 g0 = acc[ai][0][m][0], g1 = acc[ai][0][m][1], u0 = acc[ai][1][m][0], u1 = acc[ai][1][m][1];
                u32x4 w; w.x = cvt_pk_bf16(silu_mul(g0[0], u0[0]), silu_mul(g0[1], u0[1])); w.y = cvt_pk_bf16(silu_mul(g0[2], u0[2]), silu_mul(g0[3], u0[3]));
                w.z = cvt_pk_bf16(silu_mul(g1[0], u1[0]), silu_mul(g1[1], u1[1])); w.w = cvt_pk_bf16(silu_mul(g1[2], u1[2]), silu_mul(g1[3], u1[3]));
                *(u32x4*)rowp = w; }
    }
};

struct EpiRes {
    static constexpr bool PERM = false, AFTER_DRAIN = false;
    const float* base; float* out; int ldc; float s;
    __device__ __forceinline__ void operator()(const f32x4 (&acc)[2][2][4][2], const Unit& u, int wr, int wc, int fr, int fq) const {
        const int row0 = u.pm * BM + wr * 64 + fr; const int col0 = u.pn * BM + wc * 32 + 4 * fq;
#pragma unroll
        for (int ai = 0; ai < 2; ++ai)
#pragma unroll
            for (int m = 0; m < 4; ++m) { const size_t off = (size_t)(row0 + ai * HALF + m * 16) * ldc + col0;
#pragma unroll
                for (int bj = 0; bj < 2; ++bj)
#pragma unroll
                    for (int n = 0; n < 2; ++n) { const f32x4 b = *(const f32x4*)(base + off + bj * HALF + n * 16); *(f32x4*)(out + off + bj * HALF + n * 16) = b + acc[ai][bj][m][n] * s; }
                asm volatile("" ::: "memory"); }
    }
};

struct EpiF32 {
    static constexpr bool PERM = false, AFTER_DRAIN = false;
    float* out; int ldc, ncols;
    __device__ __forceinline__ void operator()(const f32x4 (&acc)[2][2][4][2], const Unit& u, int wr, int wc, int fr, int fq) const {
        const int row0 = u.pm * BM + wr * 64 + fr; const int col0 = u.pn * BM + wc * 32 + 4 * fq;
#pragma unroll
        for (int ai = 0; ai < 2; ++ai)
#pragma unroll
            for (int m = 0; m < 4; ++m) { const size_t off = (size_t)(row0 + ai * HALF + m * 16) * ldc + col0;
#pragma unroll
                for (int bj = 0; bj < 2; ++bj)
#pragma unroll
                    for (int n = 0; n < 2; ++n) if (col0 + bj * HALF + n * 16 < ncols) *(f32x4*)(out + off + bj * HALF + n * 16) = acc[ai][bj][m][n]; }
    }
};


struct EpiQKNorm {
    static constexpr bool PERM = true, AFTER_DRAIN = false;
    bf16_t* O; int ldc; const float* gq; const float* gk; PG8_LAS float* ps; float qs;
    __device__ __forceinline__ void operator()(const f32x4 (&acc)[2][2][4][2], const Unit& u, int wr, int wc, int fr, int fq) const {
        const int row0 = u.pm * BM + wr * 64 + fr; const int col0 = u.pn * BM + wc * 32 + 8 * fq;
        if (u.pn >= 24) {
#pragma unroll
            for (int ai = 0; ai < 2; ++ai)
#pragma unroll
                for (int m = 0; m < 4; ++m) { bf16_t* rowp = O + (size_t)(row0 + ai * HALF + m * 16) * ldc + col0;
#pragma unroll
                    for (int bj = 0; bj < 2; ++bj) { const f32x4 v0 = acc[ai][bj][m][0], v1 = acc[ai][bj][m][1];
                        u32x4 w; w.x = cvt_pk_bf16(v0[0], v0[1]); w.y = cvt_pk_bf16(v0[2], v0[3]); w.z = cvt_pk_bf16(v1[0], v1[1]); w.w = cvt_pk_bf16(v1[2], v1[3]);
                        *(u32x4*)(rowp + bj * HALF) = w; } }
            return;
        }
        const bool isq = u.pn < 12; const float* g = (isq ? gq : gk) + wc * 32 + 8 * fq; const float sc = isq ? qs : 1.0f;
        const f32x4 g0 = *(const f32x4*)g, g1 = *(const f32x4*)(g + 4);
#pragma unroll
        for (int ai = 0; ai < 2; ++ai)
#pragma unroll
            for (int m = 0; m < 4; ++m)
#pragma unroll
                for (int bj = 0; bj < 2; ++bj) { const f32x4 a = acc[ai][bj][m][0], b = acc[ai][bj][m][1];
                    float s = ((a[0] * a[0] + a[1] * a[1]) + (a[2] * a[2] + a[3] * a[3])) + ((b[0] * b[0] + b[1] * b[1]) + (b[2] * b[2] + b[3] * b[3]));
                    s += __shfl_xor(s, 16); s += __shfl_xor(s, 32);
                    if (fq == 0) ps[((ai * HALF + wr * 64 + m * 16 + fr) * 2 + bj) * 4 + wc] = s; }
        asm volatile("s_waitcnt lgkmcnt(0)" ::: "memory"); __builtin_amdgcn_s_barrier(); asm volatile("" ::: "memory");
#pragma unroll
        for (int ai = 0; ai < 2; ++ai)
#pragma unroll
            for (int m = 0; m < 4; ++m) { bf16_t* rowp = O + (size_t)(row0 + ai * HALF + m * 16) * ldc + col0;
#pragma unroll
                for (int bj = 0; bj < 2; ++bj) { const f32x4 p = *(const PG8_LAS f32x4*)(ps + ((ai * HALF + wr * 64 + m * 16 + fr) * 2 + bj) * 4);
                    const float rs = __builtin_amdgcn_rsqf(((p[0] + p[1]) + (p[2] + p[3])) * (1.0f / 128.0f) + 1e-6f) * sc;
                    const f32x4 v0 = acc[ai][bj][m][0] * rs * g0, v1 = acc[ai][bj][m][1] * rs * g1;
                    u32x4 w; w.x = cvt_pk_bf16(v0[0], v0[1]); w.y = cvt_pk_bf16(v0[2], v0[3]); w.z = cvt_pk_bf16(v1[0], v1[1]); w.w = cvt_pk_bf16(v1[2], v1[3]);
                    *(u32x4*)(rowp + bj * HALF) = w; } }
        asm volatile("s_waitcnt lgkmcnt(0)" ::: "memory"); __builtin_amdgcn_s_barrier(); asm volatile("" ::: "memory");
    }
};

struct EpiQKV2 {
    static constexpr bool PERM = true, AFTER_DRAIN = false;
    bf16_t* Oq; bf16_t* Okv; int ldq, ldkv, nq, nmq;
    __device__ __forceinline__ void operator()(const f32x4 (&acc)[2][2][4][2], const Unit& u, int wr, int wc, int fr, int fq) const {
        const bool isq = u.pn < nq;
        bf16_t* O = isq ? Oq : Okv; const int ldc = isq ? ldq : ldkv; const int pm = isq ? u.pm : u.pm - nmq, pn = isq ? u.pn : u.pn - nq;
        const int row0 = pm * BM + wr * 64 + fr; const int col0 = pn * BM + wc * 32 + 8 * fq;
#pragma unroll
        for (int ai = 0; ai < 2; ++ai)
#pragma unroll
            for (int m = 0; m < 4; ++m) { bf16_t* rowp = O + (size_t)(row0 + ai * HALF + m * 16) * ldc + col0;
#pragma unroll
                for (int bj = 0; bj < 2; ++bj) { const f32x4 v0 = acc[ai][bj][m][0], v1 = acc[ai][bj][m][1];
                    u32x4 w; w.x = cvt_pk_bf16(v0[0], v0[1]); w.y = cvt_pk_bf16(v0[2], v0[3]); w.z = cvt_pk_bf16(v1[0], v1[1]); w.w = cvt_pk_bf16(v1[2], v1[3]);
                    *(u32x4*)(rowp + bj * HALF) = w; } }
    }
};
template <class Epi, class Sched, bool ALIGN_EPI = false, bool SP2 = false>
__device__ __forceinline__ void gemm_phase(PG8_LAS unsigned char* lds, const Gemm g, const Sched S, const Epi E) {
    int tid_o = threadIdx.x; asm volatile("" : "+v"(tid_o));
    const int tid = tid_o, wid = __builtin_amdgcn_readfirstlane(tid >> 6), lane = tid & 63, wr = wid >> 2, wc = wid & 3, fr = lane & 15, fq = lane >> 4;
    const int K = g.K, nt = K / BK;
    unsigned voffA[2], voffB[2];
#pragma unroll
    for (int i = 0; i < 2; ++i) { int R, C; stage_rc(tid * 16 + i * 8192, R, C); const int Rb = Epi::PERM ? ((R & ~31) + perm32(R & 31)) : R;
        voffA[i] = (unsigned)(R * K + C) * 2u; voffB[i] = (unsigned)(Rb * K + C) * 2u; }
    const size_t kstep = (size_t)(BK * 2);
    const size_t hstep = (size_t)HALF * K * 2;
    const size_t tstep = 2 * hstep;
    const unsigned ldsw = (unsigned)wid * 1024u;
    const int aoff = lds_byte(wr * 64 + fr, fq * 8), boff = lds_byte(wc * 32 + fr, fq * 8);
#define PG8_SA(b, h) (((b) * 2 + (h)) * HTB)
#define PG8_SB(b, h) ((4 + (b) * 2 + (h)) * HTB)
#define PG8_STAGE(bufoff, gbase, voff) do { _Pragma("unroll") for (int _i = 0; _i < 2; ++_i) \
        __builtin_amdgcn_global_load_lds((const unsigned*)((const char*)(gbase) + (voff)[_i]), (PG8_LAS unsigned*)(lds + (bufoff) + ldsw + _i * 8192), 16, 0, 0); } while (0)
#define PG8_LDA(dst, b, h) do { _Pragma("unroll") for (int m = 0; m < 4; ++m) _Pragma("unroll") for (int k = 0; k < 2; ++k) dst[m][k] = *(const PG8_LAS bf16x8*)(lds + PG8_SA(b, h) + aoff + m * 2048 + k * 1024); } while (0)
#define PG8_LDB(dst, b, h) do { _Pragma("unroll") for (int n = 0; n < 2; ++n) _Pragma("unroll") for (int k = 0; k < 2; ++k) dst[n][k] = *(const PG8_LAS bf16x8*)(lds + PG8_SB(b, h) + boff + n * 2048 + k * 1024); } while (0)
#define PG8_MMA(ai, bj, At, Bt) do { __builtin_amdgcn_s_setprio(1); _Pragma("unroll") for (int m = 0; m < 4; ++m) _Pragma("unroll") for (int n = 0; n < 2; ++n) _Pragma("unroll") for (int k = 0; k < 2; ++k) \
        acc[ai][bj][m][n] = __builtin_amdgcn_mfma_f32_16x16x32_bf16(Bt[n][k], At[m][k], acc[ai][bj][m][n], 0, 0, 0); __builtin_amdgcn_s_setprio(0); } while (0)
#define PG8_WAIT_V(n) asm volatile("s_waitcnt vmcnt(" #n ")" ::: "memory")
#define PG8_WAIT_L(n) asm volatile("s_waitcnt lgkmcnt(" #n ")" ::: "memory")
#define PG8_BAR __builtin_amdgcn_s_barrier()
#define PG8_SCHED __builtin_amdgcn_sched_barrier(0)
    Unit cur, nxt; int ui = 0;
    if (!S.next(0, cur)) return;
    f32x4 acc[2][2][4][2];
#pragma unroll
    for (int a = 0; a < 2; ++a)
#pragma unroll
        for (int b = 0; b < 2; ++b)
#pragma unroll
            for (int m = 0; m < 4; ++m)
#pragma unroll
                for (int n = 0; n < 2; ++n) acc[a][b][m][n] = (f32x4){0.f, 0.f, 0.f, 0.f};
    bf16x8 At[4][2], B0[2][2], B1[2][2];
    const char* cA = (const char*)g.A + (size_t)cur.pm * tstep; const char* cB = (const char*)g.Bt + (size_t)cur.pn * tstep;
    S.a_ready(cur);
    if constexpr (SP2) {
        PG8_STAGE(PG8_SB(0, 0), cB, voffB); PG8_STAGE(PG8_SB(0, 1), cB + hstep, voffB); PG8_STAGE(PG8_SA(0, 0), cA, voffA); PG8_STAGE(PG8_SA(0, 1), cA + hstep, voffA);
        if (wr == 1) PG8_BAR;
        PG8_WAIT_V(2); PG8_BAR;
        PG8_STAGE(PG8_SB(1, 0), cB + kstep, voffB); PG8_STAGE(PG8_SA(1, 0), cA + kstep, voffA); PG8_STAGE(PG8_SB(1, 1), cB + hstep + kstep, voffB);
        PG8_WAIT_V(6); PG8_BAR;
    } else {
        PG8_STAGE(PG8_SB(0, 0), cB, voffB); PG8_STAGE(PG8_SA(0, 0), cA, voffA); PG8_STAGE(PG8_SB(0, 1), cB + hstep, voffB); PG8_STAGE(PG8_SA(0, 1), cA + hstep, voffA);
        if (wr == 1) PG8_BAR;
        PG8_WAIT_V(4); PG8_BAR;
        PG8_STAGE(PG8_SB(1, 0), cB + kstep, voffB); PG8_STAGE(PG8_SA(1, 0), cA + kstep, voffA); PG8_STAGE(PG8_SB(1, 1), cB + hstep + kstep, voffB);
        PG8_WAIT_V(6); PG8_BAR;
    }
    for (;;) {
        const bool has_next = S.next(ui + 1, nxt);
        const char* nA = has_next ? (const char*)g.A + (size_t)nxt.pm * tstep : cA; const char* nB = has_next ? (const char*)g.Bt + (size_t)nxt.pn * tstep : cB;
        for (int t = 0; t < nt; t += 2) {
            const bool last = (t == nt - 2);
            const char* a1 = cA + (size_t)(t + 1) * kstep;
            const char* a2 = last ? nA : cA + (size_t)(t + 2) * kstep; const char* b2 = last ? nB : cB + (size_t)(t + 2) * kstep;
            const char* a3 = a2 + kstep; const char* b3 = b2 + kstep;
            if (last && has_next) S.a_ready(nxt);
            if constexpr (SP2) {
            PG8_LDB(B0, 0, 0); PG8_LDB(B1, 0, 1); PG8_SCHED; PG8_LDA(At, 0, 0); PG8_STAGE(PG8_SA(1, 1), a1 + hstep, voffA);
            PG8_WAIT_V(8); PG8_WAIT_L(0); PG8_BAR; PG8_MMA(0, 0, At, B0); PG8_MMA(0, 1, At, B1); PG8_BAR; PG8_SCHED;
            PG8_LDA(At, 0, 1); PG8_STAGE(PG8_SB(0, 0), b2, voffB); PG8_STAGE(PG8_SB(0, 1), b2 + hstep, voffB); PG8_STAGE(PG8_SA(0, 0), a2, voffA);
            PG8_WAIT_V(8); PG8_WAIT_L(0); PG8_BAR; PG8_MMA(1, 0, At, B0); PG8_MMA(1, 1, At, B1); PG8_BAR; PG8_SCHED;
            PG8_LDB(B0, 1, 0); PG8_LDB(B1, 1, 1); PG8_SCHED; PG8_LDA(At, 1, 0); PG8_STAGE(PG8_SA(0, 1), a2 + hstep, voffA);
            PG8_WAIT_V(8); PG8_WAIT_L(0); PG8_BAR; PG8_MMA(0, 0, At, B0); PG8_MMA(0, 1, At, B1); PG8_BAR; PG8_SCHED;
            PG8_LDA(At, 1, 1); PG8_STAGE(PG8_SB(1, 0), b3, voffB); PG8_STAGE(PG8_SB(1, 1), b3 + hstep, voffB); PG8_STAGE(PG8_SA(1, 0), a3, voffA);
            PG8_WAIT_V(8); PG8_WAIT_L(0); PG8_BAR; PG8_MMA(1, 0, At, B0); PG8_MMA(1, 1, At, B1); PG8_BAR; PG8_SCHED;
            } else {
            PG8_LDB(B0, 0, 0); PG8_SCHED; PG8_LDA(At, 0, 0); PG8_STAGE(PG8_SA(1, 1), a1 + hstep, voffA);
            PG8_WAIT_L(8); PG8_BAR; PG8_WAIT_L(0); PG8_MMA(0, 0, At, B0); PG8_BAR; PG8_SCHED;
            PG8_LDB(B1, 0, 1); PG8_STAGE(PG8_SB(0, 0), b2, voffB);
            PG8_BAR; PG8_WAIT_L(0); PG8_MMA(0, 1, At, B1); PG8_BAR;
            PG8_LDA(At, 0, 1); PG8_STAGE(PG8_SA(0, 0), a2, voffA);
            PG8_BAR; PG8_WAIT_L(0); PG8_MMA(1, 0, At, B0); PG8_BAR; PG8_SCHED;
            PG8_STAGE(PG8_SB(0, 1), b2 + hstep, voffB);
            PG8_WAIT_V(6); PG8_BAR; PG8_MMA(1, 1, At, B1); PG8_BAR;
            PG8_LDB(B0, 1, 0); PG8_SCHED; PG8_LDA(At, 1, 0); PG8_STAGE(PG8_SA(0, 1), a2 + hstep, voffA);
            PG8_WAIT_L(8); PG8_BAR; PG8_WAIT_L(0); PG8_MMA(0, 0, At, B0); PG8_BAR; PG8_SCHED;
            PG8_LDB(B1, 1, 1); PG8_STAGE(PG8_SB(1, 0), b3, voffB);
            PG8_BAR; PG8_WAIT_L(0); PG8_MMA(0, 1, At, B1); PG8_BAR;
            PG8_LDA(At, 1, 1); PG8_STAGE(PG8_SA(1, 0), a3, voffA);
            PG8_BAR; PG8_WAIT_L(0); PG8_MMA(1, 0, At, B0); PG8_BAR; PG8_SCHED;
            PG8_STAGE(PG8_SB(1, 1), b3 + hstep, voffB);
            PG8_WAIT_V(6); PG8_BAR; PG8_MMA(1, 1, At, B1); PG8_BAR;
            }
        }
        if constexpr (ALIGN_EPI) { if (wr == 0) PG8_BAR; }
        if constexpr (!Epi::AFTER_DRAIN) { E(acc, cur, wr, wc, fr, fq); S.done(cur); }
        if (!has_next) break;
#pragma unroll
        for (int a = 0; a < 2; ++a)
#pragma unroll
            for (int b = 0; b < 2; ++b)
#pragma unroll
                for (int m = 0; m < 4; ++m)
#pragma unroll
                    for (int n = 0; n < 2; ++n) acc[a][b][m][n] = (f32x4){0.f, 0.f, 0.f, 0.f};
        cur = nxt; cA = nA; cB = nB; ++ui;
        if constexpr (ALIGN_EPI) { if (wr == 1) PG8_BAR; }
    }
    PG8_WAIT_V(0);
    if constexpr (!ALIGN_EPI) { if (wr == 0) PG8_BAR; }
    PG8_BAR;
    if constexpr (Epi::AFTER_DRAIN) { E.fused(acc, cur, wr, wc, fr, fq, lds, wid, lane); S.done(cur); }
#undef PG8_SA
#undef PG8_SB
#undef PG8_STAGE
#undef PG8_LDA
#undef PG8_LDB
#undef PG8_MMA
#undef PG8_WAIT_V
#undef PG8_WAIT_L
#undef PG8_BAR
#undef PG8_SCHED
}
}

#define GAS __attribute__((address_space(1)))
#define LAS __attribute__((address_space(3)))
typedef unsigned short bf16;
typedef unsigned v4u __attribute__((ext_vector_type(4)));
typedef unsigned v2u __attribute__((ext_vector_type(2)));
typedef float f32x4 __attribute__((ext_vector_type(4)));

constexpr int NWAVES = 8;
constexpr int BATCH = 4, SEQ = 4096, D = 2048, M = BATCH * SEQ, FF = 5632;
constexpr int QL = 512, KVL = 512, NOPE = 128, ROPE = 64, VD = 128, QKD = 192, MH = 16;
constexpr int NLAT = QL + KVL + ROPE;
constexpr int NLATP = 1280;
constexpr int NQ = MH * QKD;
constexpr int KVROW = 256;
constexpr int NKV = MH * KVROW;
constexpr int DG = 3, DH = 8, DHD = 128;
constexpr int NQKV = 3 * DG * DH * DHD;
constexpr int DO = DH * DHD;
constexpr float EPS = 1e-6f;
constexpr float LOG2E = 1.4426950408889634f;

constexpr size_t MiB = 1u << 20;
constexpr size_t WS_FFN = 1 * MiB;
constexpr size_t FFN_STRIDE = 66 * MiB, FFN_WOUT = 44 * MiB;
constexpr size_t WS_DOWN = WS_FFN + 4 * FFN_STRIDE;
constexpr size_t WS_UQ = WS_DOWN + 5 * MiB;
constexpr size_t WS_UKV = WS_UQ + 3 * MiB;
constexpr size_t WS_MWO = WS_UKV + 5 * MiB;
constexpr size_t WS_DQKV = WS_MWO + 8 * MiB;
constexpr size_t WS_DWO = WS_DQKV + 36 * MiB;
constexpr size_t WS_XN = WS_DWO + 4 * MiB;
constexpr size_t WS_R = WS_XN + 64 * MiB;
constexpr size_t WS_H = WS_R;
constexpr size_t WS_LAT = WS_R;
constexpr size_t WS_CQ = WS_LAT + 80 * MiB;
constexpr size_t WS_CKV = WS_CQ + 16 * MiB;
constexpr size_t WS_Q = WS_CKV + 16 * MiB;
constexpr size_t WS_KV = WS_Q + 96 * MiB;
constexpr size_t WS_MO = WS_R;
constexpr size_t WS_QKV = WS_R;
constexpr size_t WS_DOUT = WS_QKV + 288 * MiB;
constexpr size_t WS_KPE = WS_KV + 128 * MiB;
constexpr size_t WS_END = WS_KV + 160 * MiB;
static_assert(WS_DOUT + 32 * MiB <= WS_END, "ws map");

constexpr int LDS_CTL = 131072;
constexpr int LDS_PS = LDS_CTL + 1024;
constexpr int LDS_BYTES = LDS_PS + 8192;

#define LDS_WAIT() asm volatile("s_waitcnt lgkmcnt(0)" ::: "memory")
__device__ __forceinline__ unsigned pk2(float lo, float hi) { return pg8::cvt_pk_bf16(lo, hi); }
__device__ __forceinline__ float bflo(unsigned w) { return __uint_as_float(w << 16); }
__device__ __forceinline__ float bfhi(unsigned w) { return __uint_as_float(w & 0xffff0000u); }
__device__ __forceinline__ float wave_sum(float v) {
#pragma unroll
    for (int o = 1; o < 64; o <<= 1) v += __shfl_xor(v, o);
    return v;
}

template <int MAP> __device__ __forceinline__ int map_row(int n0) {
    if (MAP == 1) { const int isup = n0 >= FF ? 1 : 0; const int c = n0 - isup * FF; return (c >> 7) * 256 + isup * 128 + (c & 127); }
    if (MAP == 2) { const int head = n0 >> 8, w = n0 & 255; return head * KVROW + (w < 128 ? w : w + 64); }
    return n0;
}
template <int MAP> __device__ __forceinline__ void conv_matrix(const float* W, int K, int N, bf16* WT, LAS float* scr, int gw, int NGW, int lane) {
    const int nblk = N / 32, nitems = (K / 64) * nblk;
    for (int it = gw; it < nitems; it += NGW) {
        const int kb = it / nblk, nb = it % nblk, k0 = 64 * kb, n0 = 32 * nb;
#pragma unroll 8
        for (int i = 0; i < 32; ++i) { const int kk = 2 * i + (lane >> 5); scr[kk * 33 + (lane & 31)] = W[(size_t)(k0 + kk) * N + n0 + (lane & 31)]; }
        LDS_WAIT(); asm volatile("" ::: "memory");
        const int c = lane & 7; const int r0 = map_row<MAP>(n0);
#pragma unroll
        for (int j = 0; j < 4; ++j) { const int n = (lane >> 3) + 8 * j; const LAS float* s = scr + (8 * c) * 33 + n;
            v4u o; o.x = pk2(s[0 * 33], s[1 * 33]); o.y = pk2(s[2 * 33], s[3 * 33]); o.z = pk2(s[4 * 33], s[5 * 33]); o.w = pk2(s[6 * 33], s[7 * 33]);
            *(v4u*)(WT + (size_t)(r0 + n) * K + k0 + 8 * c) = o; }
        LDS_WAIT(); asm volatile("" ::: "memory");
    }
}

struct Args { const float* in[20]; float* out; unsigned char* ws; int ph_lo, ph_hi; };

enum { I_X = 0, I_F1N, I_F1WI, I_F1WO, I_MIXN, I_F2N, I_F2WI, I_F2WO, I_MDOWN, I_MGCQ, I_MGCKV, I_MUQ, I_MUKV, I_MGQN, I_MGKN, I_MWO, I_DQKV, I_DGQN, I_DGKN, I_DWO };

__device__ __forceinline__ void rms_row_to_bf16(const float* xrow, const float* g, bf16* orow, int lane) {
    const f32x4* xr = (const f32x4*)xrow + lane;
    f32x4 v[8]; float s = 0.f;
#pragma unroll
    for (int j = 0; j < 8; ++j) { v[j] = xr[64 * j]; s += (v[j].x * v[j].x + v[j].y * v[j].y) + (v[j].z * v[j].z + v[j].w * v[j].w); }
    const float rs = 1.0f / sqrtf(wave_sum(s) * (1.f / D) + EPS);
    const f32x4* gr = (const f32x4*)g + lane;
    v2u* o8 = (v2u*)orow + lane;
#pragma unroll
    for (int j = 0; j < 8; ++j) { const f32x4 gg = gr[64 * j]; v2u w; w.x = pk2(v[j].x * rs * gg.x, v[j].y * rs * gg.y); w.y = pk2(v[j].z * rs * gg.z, v[j].w * rs * gg.w); o8[64 * j] = w; }
}

__device__ __forceinline__ void unpack8(const v4u w, float* f) {
    f[0] = bflo(w.x); f[1] = bfhi(w.x); f[2] = bflo(w.y); f[3] = bfhi(w.y); f[4] = bflo(w.z); f[5] = bfhi(w.z); f[6] = bflo(w.w); f[7] = bfhi(w.w);
}

__device__ __forceinline__ void mla_attn_naive_unit(const bf16* Q, const bf16* KV, bf16* O, int b, int h, int qt, int tid) {
    const int qi = tid >> 2, dq = tid & 3, q0 = qt * 128, myq = q0 + qi;
    float qv[48];
    { const v4u* qp = (const v4u*)(Q + (size_t)(b * SEQ + myq) * NQ + h * QKD + 48 * dq);
#pragma unroll
      for (int i = 0; i < 6; ++i) unpack8(qp[i], qv + 8 * i); }
    float o[32];
#pragma unroll
    for (int e = 0; e < 32; ++e) o[e] = 0.f;
    float mx = -1e30f, l = 0.f;
    const bf16* kvb = KV + (size_t)(b * SEQ) * NKV + h * KVROW;
    const int nk = q0 + 128;
#pragma unroll 1
    for (int j = 0; j < nk; ++j) {
        const bf16* kr = kvb + (size_t)j * NKV;
        const v4u* kp = (const v4u*)(kr + 48 * dq);
        float part = 0.f;
#pragma unroll
        for (int i = 0; i < 6; ++i) { float kf[8]; unpack8(kp[i], kf);
#pragma unroll
            for (int e = 0; e < 8; ++e) part += qv[8 * i + e] * kf[e]; }
        part += __shfl_xor(part, 1); part += __shfl_xor(part, 2);
        if (j <= myq) {
            const float mn = fmaxf(mx, part), corr = __builtin_amdgcn_exp2f(mx - mn), p = __builtin_amdgcn_exp2f(part - mn);
            l = l * corr + p; mx = mn;
            const v4u* vp = (const v4u*)(kr + 192 + 32 * dq);
#pragma unroll
            for (int i = 0; i < 4; ++i) { float vf[8]; unpack8(vp[i], vf);
#pragma unroll
                for (int e = 0; e < 8; ++e) o[8 * i + e] = o[8 * i + e] * corr + p * vf[e]; }
        }
    }
    const float rl = 1.0f / l;
    v4u* op = (v4u*)(O + (size_t)(b * SEQ + myq) * D + h * VD + 32 * dq);
#pragma unroll
    for (int i = 0; i < 4; ++i) { v4u w; w.x = pk2(o[8 * i] * rl, o[8 * i + 1] * rl); w.y = pk2(o[8 * i + 2] * rl, o[8 * i + 3] * rl); w.z = pk2(o[8 * i + 4] * rl, o[8 * i + 5] * rl); w.w = pk2(o[8 * i + 6] * rl, o[8 * i + 7] * rl); op[i] = w; }
}

__device__ __forceinline__ void dil_attn_naive_unit(const bf16* QKV, bf16* O, int tile, int h, int tid) {
    const int ti = tid >> 2, dq = tid & 3, tok = tile * 128 + ti, b = tok / SEQ, t = tok % SEQ;
    float o[32];
#pragma unroll
    for (int e = 0; e < 32; ++e) o[e] = 0.f;
    float mx = -1e30f, l = 0.f;
#pragma unroll 1
    for (int g = 0; g < DG; ++g) {
        const int sh = 2 * g, dil = 1 << sh;
        const float slope2 = __builtin_amdgcn_exp2f(-(float)(g * DH + h + 1) * (1.0f / 3.0f)) * (float)dil * LOG2E;
        float qv[32];
        { const v4u* qp = (const v4u*)(QKV + (size_t)tok * NQKV + g * DO + h * DHD + 32 * dq);
#pragma unroll
          for (int i = 0; i < 4; ++i) unpack8(qp[i], qv + 8 * i); }
#pragma unroll 1
        for (int j = 0; j <= 128; ++j) {
            const int pos = t - (j << sh); const bool ok = pos >= 0; const int pc = ok ? pos : 0;
            const bf16* kr = QKV + (size_t)(b * SEQ + pc) * NQKV + 3072 + g * DO + h * DHD + 32 * dq;
            const v4u* kp = (const v4u*)kr;
            float part = 0.f;
#pragma unroll
            for (int i = 0; i < 4; ++i) { float kf[8]; unpack8(kp[i], kf);
#pragma unroll
                for (int e = 0; e < 8; ++e) part += qv[8 * i + e] * kf[e]; }
            part += __shfl_xor(part, 1); part += __shfl_xor(part, 2);
            const float s = part - slope2 * (float)j;
            if (ok) {
                const float mn = fmaxf(mx, s), corr = __builtin_amdgcn_exp2f(mx - mn), p = __builtin_amdgcn_exp2f(s - mn);
                l = l * corr + p; mx = mn;
                const v4u* vp = (const v4u*)(kr + 3072);
#pragma unroll
                for (int i = 0; i < 4; ++i) { float vf[8]; unpack8(vp[i], vf);
#pragma unroll
                    for (int e = 0; e < 8; ++e) o[8 * i + e] = o[8 * i + e] * corr + p * vf[e]; }
            }
        }
    }
    const float rl = 1.0f / l;
    v4u* op = (v4u*)(O + (size_t)tok * DO + h * DHD + 32 * dq);
#pragma unroll
    for (int i = 0; i < 4; ++i) { v4u w; w.x = pk2(o[8 * i] * rl, o[8 * i + 1] * rl); w.y = pk2(o[8 * i + 2] * rl, o[8 * i + 3] * rl); w.z = pk2(o[8 * i + 4] * rl, o[8 * i + 5] * rl); w.w = pk2(o[8 * i + 6] * rl, o[8 * i + 7] * rl); op[i] = w; }
}


#define XB_TMO      128
#define XB_XCNT(j)  (256  + 64 * (j))
#define XB_XSUB(j)  (1280 + 64 * (j))
#define XB_XGEN(j)  (2304 + 64 * (j))
#define XB_TOP      3328
#define XB_TOPGEN   3392
#define XCD_BAR_WORDS 3456
#define XB_SPIN_CAP (1u << 18)

__device__ __forceinline__ unsigned xb_ld(unsigned* p)              { return __hip_atomic_load(p, __ATOMIC_RELAXED, __HIP_MEMORY_SCOPE_AGENT); }
__device__ __forceinline__ unsigned xb_add(unsigned* p, unsigned v) { return __hip_atomic_fetch_add(p, v, __ATOMIC_RELAXED, __HIP_MEMORY_SCOPE_AGENT); }
__device__ __forceinline__ unsigned xb_xcc_id() { return (unsigned)__builtin_amdgcn_s_getreg((3 << 11) | 20) & 0xFu; }
#define XB_SPIN(cond, bar) do { unsigned _sp = 0; while (cond) { __builtin_amdgcn_s_sleep(1); \
    if ((++_sp & 255u) == 0u) { if (xb_ld(&(bar)[XB_TMO])) break; if (_sp > XB_SPIN_CAP) { atomicAdd(&(bar)[XB_TMO], 1u); break; } } } } while (0)

struct XcdBarrier {
    unsigned* bar; unsigned x;
    volatile LAS unsigned* st;
};

__device__ __forceinline__ XcdBarrier xcd_barrier_post(unsigned* bar, volatile LAS unsigned* st) {
    XcdBarrier b; b.bar = bar; b.x = xb_xcc_id(); b.st = st;
    if (threadIdx.x == 0) (void)xb_add(&bar[XB_XCNT(b.x)], 1u);
    return b;
}
__device__ __forceinline__ void xcd_barrier_complete(unsigned* bar, unsigned x, unsigned& nloc, unsigned& nx) {
    const unsigned G = gridDim.x * gridDim.y * gridDim.z;
    unsigned sum, cnt, mine, sp = 0u;
    for (;;) {
        sum = 0u; cnt = 0u; mine = 0u;
#pragma unroll
        for (unsigned j = 0; j < 16; ++j) { const unsigned c = xb_ld(&bar[XB_XCNT(j)]); sum += c; cnt += (c > 0u) ? 1u : 0u; mine = (j == x) ? c : mine; }
        if (sum == G) break;
        __builtin_amdgcn_s_sleep(1);
        if ((++sp & 255u) == 0u) { if (xb_ld(&bar[XB_TMO])) break; if (sp > XB_SPIN_CAP) { atomicAdd(&bar[XB_TMO], 1u); break; } }
    }
    nloc = mine > 0u ? mine : 1u; nx = cnt > 0u ? cnt : 1u;
}

__device__ __forceinline__ void xcd_barrier(const XcdBarrier& b) {
    asm volatile("s_waitcnt vmcnt(0)" ::: "memory");
    __syncthreads();
    if (threadIdx.x == 0) {
        unsigned* bar = b.bar;
        __builtin_amdgcn_s_waitcnt(0);
        unsigned nloc = b.st[0], nx = b.st[1];
        if (nloc == 0u) { xcd_barrier_complete(bar, b.x, nloc, nx); b.st[0] = nloc; b.st[1] = nx; }
        const unsigned old = xb_add(&bar[XB_XSUB(b.x)], 1u);
        const unsigned gen = old / nloc;
        if (old + 1u == (gen + 1u) * nloc) {
            __builtin_amdgcn_fence(__ATOMIC_RELEASE, "agent");
            asm volatile("s_waitcnt vmcnt(0)" ::: "memory");
            const unsigned og = xb_add(&bar[XB_TOP], 1u);
            const unsigned tg = og / nx;
            if (og + 1u == (tg + 1u) * nx) xb_add(&bar[XB_TOPGEN], 1u);
            else XB_SPIN(xb_ld(&bar[XB_TOPGEN]) == tg, bar);
            __builtin_amdgcn_fence(__ATOMIC_ACQUIRE, "agent");
            xb_add(&bar[XB_XGEN(b.x)], 1u);
            asm volatile("s_waitcnt vmcnt(0)" ::: "memory");
        } else {
            XB_SPIN(xb_ld(&bar[XB_XGEN(b.x)]) == gen, bar);
            __builtin_amdgcn_fence(__ATOMIC_ACQUIRE, "agent");
            asm volatile("s_waitcnt vmcnt(0)" ::: "memory");
        }
    }
    __syncthreads();
}


namespace fa {
typedef short bf16x8 __attribute__((ext_vector_type(8)));
typedef short s16x4 __attribute__((ext_vector_type(4)));
typedef float f32x16 __attribute__((ext_vector_type(16)));
#define FA_MFMA(a, b, c) __builtin_amdgcn_mfma_f32_32x32x16_bf16((a), (b), (c), 0, 0, 0)
#define FA_SB() __builtin_amdgcn_sched_barrier(0)
__device__ __forceinline__ s16x4 vtr(const LAS unsigned char* p) { return __builtin_bit_cast(s16x4, __builtin_amdgcn_ds_read_tr16_b64_v4i16((LAS s16x4*)p)); }

template <int OFF> __device__ __forceinline__ void vtr8_issue(unsigned addr, s16x4 (&lo)[4], s16x4 (&hh)[4]) {
    asm volatile("ds_read_b64_tr_b16 %0, %8 offset:%c9\n\tds_read_b64_tr_b16 %1, %8 offset:%c10\n\tds_read_b64_tr_b16 %2, %8 offset:%c11\n\tds_read_b64_tr_b16 %3, %8 offset:%c12\n\t"
                 "ds_read_b64_tr_b16 %4, %8 offset:%c13\n\tds_read_b64_tr_b16 %5, %8 offset:%c14\n\tds_read_b64_tr_b16 %6, %8 offset:%c15\n\tds_read_b64_tr_b16 %7, %8 offset:%c16"
                 : "=&v"(lo[0]), "=&v"(hh[0]), "=&v"(lo[1]), "=&v"(hh[1]), "=&v"(lo[2]), "=&v"(hh[2]), "=&v"(lo[3]), "=&v"(hh[3])
                 : "v"(addr), "i"(OFF), "i"(OFF + 2048), "i"(OFF + 512), "i"(OFF + 512 + 2048), "i"(OFF + 1024), "i"(OFF + 1024 + 2048), "i"(OFF + 1536), "i"(OFF + 1536 + 2048)
                 : "memory");
}
__device__ __forceinline__ void vtr8_wait(s16x4 (&lo)[4], s16x4 (&hh)[4]) {
    asm volatile("s_waitcnt lgkmcnt(0)" : "+v"(lo[0]), "+v"(hh[0]), "+v"(lo[1]), "+v"(hh[1]), "+v"(lo[2]), "+v"(hh[2]), "+v"(lo[3]), "+v"(hh[3]) :: "memory");
}
struct Desc {
    const bf16* Q; const bf16* K; const bf16* V; const bf16* KPE; bf16* O; float* LSE;
    long qs, ks, vs, os, kps; int lses;
    int Q0, t_lo, t_hi, W; float slope2;
};
struct ST { f32x16 a, b; };

template <int DQK, bool HAS_LSE>
__device__ __forceinline__ void unit(LAS unsigned char* lds, const Desc& d) {
    constexpr int KROW = DQK * 2, KT = 64 * KROW, VT = 16384, KCH = DQK / 8, NKS = DQK / 16, KINST = KT / 8192  , NKO = (DQK == 192) ? 4 : 8;
    constexpr int LDS_V = 3 * KT;
    static_assert(LDS_V + 3 * VT <= 131072, "attention LDS");
    int tid_o = threadIdx.x; asm volatile("" : "+v"(tid_o));
    const int tid = tid_o, lane = tid & 63, r = lane & 31, hi = lane >> 5, w = __builtin_amdgcn_readfirstlane(tid >> 6);
    const int qw = d.Q0 + 32 * w, myq = qw + r;
    const float NEG = -1e30f;
    bf16x8 qr[NKS];
    { const bf16* qp = d.Q + (long)(32 * w + r) * d.qs + 8 * hi;
#pragma unroll
      for (int ks = 0; ks < NKS; ++ks) qr[ks] = *(const bf16x8*)(qp + 16 * ks); }
    f32x16 o[4];
#pragma unroll
    for (int db = 0; db < 4; ++db)
#pragma unroll
        for (int i = 0; i < 16; ++i) o[db][i] = 0.f;
    float m = NEG, l = 0.f;
    int kso[KINST], vso[2]; bool kpe_[KINST];
#pragma unroll
    for (int i = 0; i < KINST; ++i) { const int q = 64 * (KINST * w + i) + lane, row = q / KCH, pos = q % KCH;
        const int c = (DQK == 192) ? ((pos & ~7) | ((pos & 7) ^ ((row >> 1) & 7))) : (pos ^ (row & 15));
        kpe_[i] = (DQK == 192) && (c >= 16);
        kso[i] = kpe_[i] ? row * (int)d.kps + 8 * (c - 16) : row * (int)d.ks + 8 * c; }
#pragma unroll
    for (int i = 0; i < 2; ++i) { const int q = 64 * (2 * w + i) + lane, sub = q >> 5, wi = q & 31, key = 8 * (sub >> 2) + (wi >> 2), ch = (sub & 3) * 4 + (wi & 3);
        vso[i] = key * (int)d.vs + 8 * ch; }
#define FA_DMA(t, kslot, vslot) do { const bf16* kt_ = d.K + (long)(64 * (t)) * d.ks; const bf16* vt_ = d.V + (long)(64 * (t)) * d.vs; const bf16* pt_ = (DQK == 192) ? d.KPE + (long)(64 * (t)) * d.kps : kt_; \
    _Pragma("unroll") for (int i = 0; i < KINST; ++i) __builtin_amdgcn_global_load_lds((const unsigned*)((kpe_[i] ? pt_ : kt_) + kso[i]), (LAS unsigned*)(lds + (kslot) * KT + 1024 * (KINST * w + i)), 16, 0, 0); \
    _Pragma("unroll") for (int i = 0; i < 2; ++i) __builtin_amdgcn_global_load_lds((const unsigned*)(vt_ + vso[i]), (LAS unsigned*)(lds + LDS_V + (vslot) * VT + 1024 * (2 * w + i)), 16, 0, 0); } while (0)
    int koff[NKO];
#pragma unroll
    for (int j = 0; j < NKO; ++j) koff[j] = (DQK == 192) ? (r * KROW + 16 * ((2 * j + hi) ^ ((r >> 1) & 7))) : (r * KROW + 16 * ((2 * j + hi) ^ (r & 15)));
    const int vfo = LDS_V + (4 * hi + ((lane & 15) >> 2)) * 64 + ((lane >> 4) & 1) * 32 + (lane & 3) * 8;
#define FA_KADDR(kslot, kb, ks) (lds + (kslot) * KT + koff[(DQK == 192) ? ((ks) & 3) : (ks)] + ((DQK == 192) ? 128 * ((ks) >> 2) : 0) + (kb) * 32 * KROW)

    constexpr int NI = KINST + 2;
#define FA_WAIT_NI() do { if constexpr (NI == 5) asm volatile("s_waitcnt vmcnt(5)" ::: "memory"); else asm volatile("s_waitcnt vmcnt(4)" ::: "memory"); } while (0)
    __builtin_amdgcn_s_barrier();
    FA_DMA(d.t_lo, 0, 0);
    if (d.t_lo + 1 < d.t_hi) { FA_DMA(d.t_lo + 1, 1, 1); FA_WAIT_NI(); } else { asm volatile("s_waitcnt vmcnt(0)" ::: "memory"); }
    __builtin_amdgcn_s_barrier();
    int slot = 0;
#pragma unroll 1
    for (int t = d.t_lo; t < d.t_hi; ++t) {
        const int s2n = (slot >= 1) ? slot - 1 : 2;
        const bool pre = t + 2 < d.t_hi;
        if (pre) FA_DMA(t + 2, s2n, s2n);
        const bool active = (64 * t <= qw + 31) && (64 * t + 63 >= qw - d.W);
        if (active) {
            const unsigned vba = (unsigned)(unsigned long)(lds + vfo + slot * VT);
            f32x16 p0, p1;
#pragma unroll
            for (int i = 0; i < 16; ++i) { p0[i] = 0.f; p1[i] = 0.f; }
            constexpr int PF = 3;
            bf16x8 kf0[PF], kf1[PF];
#pragma unroll
            for (int i = 0; i < PF; ++i) { kf0[i] = *(const LAS bf16x8*)FA_KADDR(slot, 0, i); kf1[i] = *(const LAS bf16x8*)FA_KADDR(slot, 1, i); }
            FA_SB();
#pragma unroll
            for (int ks = 0; ks < NKS; ++ks) {
                const bf16x8 a0 = kf0[ks % PF], a1 = kf1[ks % PF];
                p0 = FA_MFMA(a0, qr[ks], p0); p1 = FA_MFMA(a1, qr[ks], p1);
                if (ks + PF < NKS) { kf0[ks % PF] = *(const LAS bf16x8*)FA_KADDR(slot, 0, ks + PF); kf1[ks % PF] = *(const LAS bf16x8*)FA_KADDR(slot, 1, ks + PF); }
                FA_SB();
            }
            s16x4 vlo[2][4], vhh[2][4];
            vtr8_issue<0>(vba, vlo[0], vhh[0]);
            const bool full = (64 * t + 63 <= qw) && (64 * t >= qw + 31 - d.W) && (d.slope2 == 0.f);
            if (!full) {
                const int dist0 = myq - 64 * t - 4 * hi;
#pragma unroll
                for (int i = 0; i < 16; ++i) { const int d0 = dist0 - ((i & 3) + 8 * (i >> 2)), d1 = d0 - 32;
                    p0[i] = ((unsigned)d0 <= (unsigned)d.W) ? __builtin_fmaf(-d.slope2, (float)d0, p0[i]) : NEG;
                    p1[i] = ((unsigned)d1 <= (unsigned)d.W) ? __builtin_fmaf(-d.slope2, (float)d1, p1[i]) : NEG; }
            }
            float mx = fmaxf(p0[0], p1[0]);
#pragma unroll
            for (int i = 1; i < 16; ++i) mx = fmaxf(mx, fmaxf(p0[i], p1[i]));
            mx = fmaxf(mx, __shfl_xor(mx, 32));
            const float mn = fmaxf(m, mx), corr = __builtin_amdgcn_exp2f(m - mn); const bool grew = __any(mn > m); m = mn;
            float ls = 0.f;
#pragma unroll
            for (int i = 0; i < 16; ++i) { p0[i] = __builtin_amdgcn_exp2f(p0[i] - mn); p1[i] = __builtin_amdgcn_exp2f(p1[i] - mn); ls += p0[i] + p1[i]; }
            l = l * corr + ls;
            if (grew) {
#pragma unroll
                for (int db = 0; db < 4; ++db)
#pragma unroll
                    for (int i = 0; i < 16; ++i) o[db][i] *= corr;
            }
#pragma unroll
            for (int g4 = 0; g4 < 4; ++g4) {
                v4u pkw;
                if (g4 == 0) { pkw.x = pk2(p0[0], p0[1]); pkw.y = pk2(p0[2], p0[3]); pkw.z = pk2(p0[4], p0[5]); pkw.w = pk2(p0[6], p0[7]); }
                if (g4 == 1) { pkw.x = pk2(p0[8], p0[9]); pkw.y = pk2(p0[10], p0[11]); pkw.z = pk2(p0[12], p0[13]); pkw.w = pk2(p0[14], p0[15]); }
                if (g4 == 2) { pkw.x = pk2(p1[0], p1[1]); pkw.y = pk2(p1[2], p1[3]); pkw.z = pk2(p1[4], p1[5]); pkw.w = pk2(p1[6], p1[7]); }
                if (g4 == 3) { pkw.x = pk2(p1[8], p1[9]); pkw.y = pk2(p1[10], p1[11]); pkw.z = pk2(p1[12], p1[13]); pkw.w = pk2(p1[14], p1[15]); }
                const bf16x8 pf = __builtin_bit_cast(bf16x8, pkw);
                vtr8_wait(vlo[g4 & 1], vhh[g4 & 1]);
                if (g4 == 0) vtr8_issue<4096>(vba, vlo[1], vhh[1]);
                if (g4 == 1) vtr8_issue<8192>(vba, vlo[0], vhh[0]);
                if (g4 == 2) vtr8_issue<12288>(vba, vlo[1], vhh[1]);
#pragma unroll
                for (int db = 0; db < 4; ++db) {
                    const bf16x8 vf = __builtin_shufflevector(vlo[g4 & 1][db], vhh[g4 & 1][db], 0, 1, 2, 3, 4, 5, 6, 7);
                    o[db] = FA_MFMA(vf, pf, o[db]);
                }
            }
        }
        if (pre) FA_WAIT_NI(); else asm volatile("s_waitcnt vmcnt(0)" ::: "memory");
        asm volatile("s_waitcnt lgkmcnt(0)" ::: "memory");
        __builtin_amdgcn_s_barrier();
        slot = (slot == 2) ? 0 : slot + 1;
    }
    int tid_e = threadIdx.x; asm volatile("" : "+v"(tid_e));
    const int r_e = tid_e & 31, hi_e = (tid_e >> 5) & 1;
    l += __shfl_xor(l, 32);
    const float inv = 1.0f / l;
    bf16* op = d.O + (long)(32 * w + r_e) * d.os + 4 * hi_e;
#pragma unroll
    for (int db = 0; db < 4; ++db)
#pragma unroll
        for (int g = 0; g < 4; ++g) { v2u wv; wv.x = pk2(o[db][4 * g] * inv, o[db][4 * g + 1] * inv); wv.y = pk2(o[db][4 * g + 2] * inv, o[db][4 * g + 3] * inv); *(v2u*)(op + 32 * db + 8 * g) = wv; }
    if (HAS_LSE) { if (hi_e == 0) d.LSE[(long)(32 * w + r_e) * d.lses] = m + __builtin_amdgcn_logf(l); }
#undef FA_DMA
#undef FA_WAIT_NI
#undef FA_KADDR
}
}
__global__ void __launch_bounds__(NWAVES * 64, 2) mega_fwd(Args args) {
    extern __shared__ __attribute__((aligned(16))) unsigned char lds[];
    cg::grid_group grid = cg::this_grid();
    LAS unsigned char* ldsp = (LAS unsigned char*)lds;
    const int wave = __builtin_amdgcn_readfirstlane(threadIdx.x >> 6);
    const int G = gridDim.x, bx = blockIdx.x;
    const int gw = bx * NWAVES + wave, NGW = G * NWAVES;
    unsigned char* ws = args.ws;
    const int lo = args.ph_lo, hi = args.ph_hi;
    int ph = 0;
    if (lo < 0) grid.sync();
#define IN_PH (ph >= lo && ph < hi)
#define PHV int tid = threadIdx.x; asm volatile("" : "+v"(tid)); const int lane = tid & 63; (void)lane;
#define SEAM do { if (ph >= lo && ph + 1 < hi) xcd_barrier(bar); ++ph; } while (0)

    if (threadIdx.x < 64) ((LAS unsigned*)(ldsp + LDS_CTL))[threadIdx.x] = 0u;
    __syncthreads();
    XcdBarrier bar = xcd_barrier_post((unsigned*)ws, (volatile LAS unsigned*)(ldsp + LDS_CTL));
    bf16* XN = (bf16*)(ws + WS_XN); bf16* HB = (bf16*)(ws + WS_H);
    float* xout = args.out;

#ifndef REP_CONV
#define REP_CONV 1
#endif
#ifndef REP_MLA
#define REP_MLA 1
#endif
#ifndef REP_DIL
#define REP_DIL 1
#endif
#ifndef REP_FFNIN
#define REP_FFNIN 1
#endif
#ifndef REP_RMS
#define REP_RMS 1
#endif
#ifndef REP_UQ
#define REP_UQ 1
#endif
#ifndef REP_LAT
#define REP_LAT 1
#endif
#ifndef REP_QKV
#define REP_QKV 1
#endif
#ifndef REP_FFNOUT0
#define REP_FFNOUT0 1
#endif
#ifndef EXTRA_SYNC
#define EXTRA_SYNC 0
#endif
    if (IN_PH) for (int rep_ = 0; rep_ < REP_CONV; ++rep_) { PHV
        LAS float* scr = (LAS float*)(ldsp + wave * 16384);
#pragma unroll 1
        for (int lf = 0; lf < 4; ++lf) {
            const int layer = lf >> 1, f = lf & 1;
            const float* wi = (f ? args.in[I_F2WI] : args.in[I_F1WI]) + (size_t)layer * D * 2 * FF;
            const float* wo = (f ? args.in[I_F2WO] : args.in[I_F1WO]) + (size_t)layer * FF * D;
            conv_matrix<1>(wi, D, 2 * FF, (bf16*)(ws + WS_FFN + lf * FFN_STRIDE), scr, gw, NGW, lane);
            conv_matrix<0>(wo, FF, D, (bf16*)(ws + WS_FFN + lf * FFN_STRIDE + FFN_WOUT), scr, gw, NGW, lane);
        }
        conv_matrix<0>(args.in[I_MDOWN], D, NLAT, (bf16*)(ws + WS_DOWN), scr, gw, NGW, lane);
        conv_matrix<0>(args.in[I_MUQ], QL, NQ, (bf16*)(ws + WS_UQ), scr, gw, NGW, lane);
        conv_matrix<0>(args.in[I_MUKV], KVL, MH * 256, (bf16*)(ws + WS_UKV), scr, gw, NGW, lane);
        conv_matrix<0>(args.in[I_MWO], MH * VD, D, (bf16*)(ws + WS_MWO), scr, gw, NGW, lane);
        conv_matrix<0>(args.in[I_DQKV], D, NQKV, (bf16*)(ws + WS_DQKV), scr, gw, NGW, lane);
        conv_matrix<0>(args.in[I_DWO], DO, D, (bf16*)(ws + WS_DWO), scr, gw, NGW, lane);
        for (int m = gw; m < M; m += NGW) rms_row_to_bf16(args.in[I_X] + (size_t)m * D, args.in[I_F1N], XN + (size_t)m * D, lane);
        { const int gt = bx * (NWAVES * 64) + tid, NT = G * NWAVES * 64; const v4u z = {0u, 0u, 0u, 0u};
          v4u* p1 = (v4u*)((bf16*)(ws + WS_DOWN) + (size_t)NLAT * D); const int n1 = (NLATP - NLAT) * D / 8;
          for (int i = gt; i < n1; i += NT) p1[i] = z;
        }
    }
    SEAM;

#pragma unroll 1
    for (int layer = 0; layer < 2; ++layer) {
#pragma unroll 1
        for (int f = 0; f < 2; ++f) {
            const int lf = layer * 2 + f;
            const float* xin = (lf == 0) ? args.in[I_X] : xout;
            if (lf != 0) {
            if (IN_PH) { PHV const float* g = (f ? args.in[I_F2N] : args.in[I_F1N]) + layer * D;
                for (int rep_ = 0; rep_ < REP_RMS; ++rep_) for (int m = gw; m < M; m += NGW) rms_row_to_bf16(xin + (size_t)m * D, g, XN + (size_t)m * D, lane); }
            SEAM;
            }
            if (IN_PH) for (int rep_ = 0; rep_ < REP_FFNIN; ++rep_) { PHV pg8::Gemm g{XN, (const bf16*)(ws + WS_FFN + lf * FFN_STRIDE), M, 2 * FF, D}; pg8::StaticOrder S; S.init(M, 2 * FF, G, bx);
                pg8::EpiSwiGLU E{HB, FF}; pg8::gemm_phase<pg8::EpiSwiGLU, pg8::StaticOrder, true, true>(ldsp, g, S, E); }
            SEAM;
            if (IN_PH) for (int rep_ = 0; rep_ < ((lf == 0) ? REP_FFNOUT0 : 1); ++rep_) { PHV pg8::Gemm g{HB, (const bf16*)(ws + WS_FFN + lf * FFN_STRIDE + FFN_WOUT), M, D, FF}; pg8::StaticOrder S; S.init(M, D, G, bx);
                pg8::EpiRes E{xin, xout, D, 0.5f}; pg8::gemm_phase<pg8::EpiRes, pg8::StaticOrder, true, true>(ldsp, g, S, E); }
            SEAM;
            if (f == 0) {
                if (IN_PH) { PHV const float* g = args.in[I_MIXN] + layer * D;
                    for (int m = gw; m < M; m += NGW) rms_row_to_bf16(xout + (size_t)m * D, g, XN + (size_t)m * D, lane); }
                SEAM;
                if (layer == 0) {
                    float* LAT = (float*)(ws + WS_LAT); bf16* CQ = (bf16*)(ws + WS_CQ); bf16* CKV = (bf16*)(ws + WS_CKV); bf16* QB = (bf16*)(ws + WS_Q); bf16* KVB = (bf16*)(ws + WS_KV); bf16* KPE = (bf16*)(ws + WS_KPE); bf16* MO = (bf16*)(ws + WS_MO);
                    if (IN_PH) for (int rep_ = 0; rep_ < REP_LAT; ++rep_) { PHV pg8::Gemm g{XN, (const bf16*)(ws + WS_DOWN), M, NLATP, D}; pg8::StaticOrder S; S.init(M, NLATP, G, bx);
                        pg8::EpiF32 E{LAT, NLATP, NLAT}; pg8::gemm_phase<pg8::EpiF32, pg8::StaticOrder, true, true>(ldsp, g, S, E); }
                    SEAM;
                    if (IN_PH) { PHV
                        for (int m = gw; m < M; m += NGW) {
#pragma unroll
                            for (int p = 0; p < 2; ++p) {
                                const f32x4* r = (const f32x4*)(LAT + (size_t)m * NLATP + 512 * p) + lane; const f32x4 v0 = r[0], v1 = r[64];
                                float s = (v0.x * v0.x + v0.y * v0.y) + (v0.z * v0.z + v0.w * v0.w) + (v1.x * v1.x + v1.y * v1.y) + (v1.z * v1.z + v1.w * v1.w);
                                const float rs = 1.0f / sqrtf(wave_sum(s) * (1.f / 512.f) + EPS);
                                const f32x4* gr = (const f32x4*)(p ? args.in[I_MGCKV] : args.in[I_MGCQ]) + lane; const f32x4 g0 = gr[0], g1 = gr[64];
                                v2u* o8 = (v2u*)((p ? CKV : CQ) + (size_t)m * 512) + lane;
                                v2u w; w.x = pk2(v0.x * rs * g0.x, v0.y * rs * g0.y); w.y = pk2(v0.z * rs * g0.z, v0.w * rs * g0.w); o8[0] = w;
                                w.x = pk2(v1.x * rs * g1.x, v1.y * rs * g1.y); w.y = pk2(v1.z * rs * g1.z, v1.w * rs * g1.w); o8[64] = w;
                            }
                        }
                    }
                    SEAM;
                    if (IN_PH) for (int rep_ = 0; rep_ < REP_UQ; ++rep_) { PHV
                        { static_assert(WS_CKV == WS_CQ + (size_t)M * QL * 2 && WS_UKV == WS_UQ + (size_t)NQ * QL * 2 && QL == KVL, "c_q | c_kv and Wuq^T | Wukv^T must be contiguous for the combined stream");
                          pg8::Gemm g{CQ, (const bf16*)(ws + WS_UQ), 2 * M, NQ + NKV, QL}; pg8::QKVOrder S; S.init(M, NQ, NKV, G, bx);
                          pg8::EpiQKV2 E{QB, KVB, NQ, NKV, NQ / 256, M / 256}; pg8::gemm_phase<pg8::EpiQKV2, pg8::QKVOrder, true, true>(ldsp, g, S, E); }
                    }
                    SEAM;
                    if (IN_PH) { PHV
                        const int grp = lane >> 5, p = lane & 31; const bool act = p < 24, pe1 = (p >= 16 && p < 20), pe2 = (p >= 20 && p < 24), nope = p < 16;
                        const float QS = 0.07216878364870322f * LOG2E;
                        float gq[8], gk[8];
#pragma unroll
                        for (int e = 0; e < 8; ++e) { gq[e] = 0.f; gk[e] = 0.f; }
                        if (act) { const f32x4 a0 = ((const f32x4*)args.in[I_MGQN])[2 * p], a1 = ((const f32x4*)args.in[I_MGQN])[2 * p + 1], b0 = ((const f32x4*)args.in[I_MGKN])[2 * p], b1 = ((const f32x4*)args.in[I_MGKN])[2 * p + 1];
                            gq[0] = a0.x; gq[1] = a0.y; gq[2] = a0.z; gq[3] = a0.w; gq[4] = a1.x; gq[5] = a1.y; gq[6] = a1.z; gq[7] = a1.w;
                            gk[0] = b0.x; gk[1] = b0.y; gk[2] = b0.z; gk[3] = b0.w; gk[4] = b1.x; gk[5] = b1.y; gk[6] = b1.z; gk[7] = b1.w; }
                        for (int m = gw; m < M; m += NGW) {
                            const int pos = m % SEQ;
                            float cs[8], sn[8], kpe[8];
#pragma unroll
                            for (int j = 0; j < 8; ++j) { cs[j] = 1.f; sn[j] = 0.f; kpe[j] = 0.f; }
                            if (pe1 || pe2) {
#pragma unroll
                                for (int j = 0; j < 8; ++j) { const int i = 8 * (p & 3) + j; const float inv = exp2f(-(float)i * (13.287712379549449f / 32.0f)); const float ang = (float)pos * inv; cs[j] = cosf(ang); sn[j] = sinf(ang); }
                                const f32x4 k0 = ((const f32x4*)(LAT + (size_t)m * NLATP + 1024))[2 * (p - 16)], k1 = ((const f32x4*)(LAT + (size_t)m * NLATP + 1024))[2 * (p - 16) + 1];
                                kpe[0] = k0.x; kpe[1] = k0.y; kpe[2] = k0.z; kpe[3] = k0.w; kpe[4] = k1.x; kpe[5] = k1.y; kpe[6] = k1.z; kpe[7] = k1.w;
                            }
                            v4u rq[8], rk[8];
#pragma unroll
                            for (int it = 0; it < 8; ++it) { const int h = 2 * it + grp; rq[it] = (v4u){0u, 0u, 0u, 0u}; rk[it] = (v4u){0u, 0u, 0u, 0u};
                                if (act) rq[it] = *((const v4u*)(QB + (size_t)m * NQ + h * QKD) + p);
                                if (nope) rk[it] = *((const v4u*)(KVB + (size_t)m * NKV + h * KVROW) + p); }
#pragma unroll
                            for (int it = 0; it < 8; ++it) { const int h = 2 * it + grp;
                                float x[8]; unpack8(rq[it], x);
                                float ss = 0.f;
#pragma unroll
                                for (int e = 0; e < 8; ++e) ss += x[e] * x[e];
                                ss += __shfl_xor(ss, 1); ss += __shfl_xor(ss, 2); ss += __shfl_xor(ss, 4); ss += __shfl_xor(ss, 8); ss += __shfl_xor(ss, 16);
                                float rs = 1.0f / sqrtf(ss * (1.f / 192.f) + EPS);
                                float y[8];
#pragma unroll
                                for (int e = 0; e < 8; ++e) { y[e] = x[e] * rs * gq[e]; const float oth = __shfl_xor(y[e], 4); if (pe1) y[e] = y[e] * cs[e] - oth * sn[e]; else if (pe2) y[e] = oth * sn[e] + y[e] * cs[e]; y[e] *= QS; }
                                if (act) { v4u wv; wv.x = pk2(y[0], y[1]); wv.y = pk2(y[2], y[3]); wv.z = pk2(y[4], y[5]); wv.w = pk2(y[6], y[7]); *((v4u*)(QB + (size_t)m * NQ + h * QKD) + p) = wv; }
                                unpack8(rk[it], x);
                                if (!nope) {
#pragma unroll
                                    for (int e = 0; e < 8; ++e) x[e] = kpe[e];
                                }
                                ss = 0.f;
#pragma unroll
                                for (int e = 0; e < 8; ++e) ss += x[e] * x[e];
                                ss += __shfl_xor(ss, 1); ss += __shfl_xor(ss, 2); ss += __shfl_xor(ss, 4); ss += __shfl_xor(ss, 8); ss += __shfl_xor(ss, 16);
                                rs = 1.0f / sqrtf(ss * (1.f / 192.f) + EPS);
#pragma unroll
                                for (int e = 0; e < 8; ++e) { y[e] = x[e] * rs * gk[e]; const float oth = __shfl_xor(y[e], 4); if (pe1) y[e] = y[e] * cs[e] - oth * sn[e]; else if (pe2) y[e] = oth * sn[e] + y[e] * cs[e]; }
                                if (act) { v4u wv; wv.x = pk2(y[0], y[1]); wv.y = pk2(y[2], y[3]); wv.z = pk2(y[4], y[5]); wv.w = pk2(y[6], y[7]); if (nope) *((v4u*)(KVB + (size_t)m * NKV + h * KVROW) + p) = wv; else *((v4u*)(KPE + (size_t)m * (MH * ROPE) + h * ROPE) + (p - 16)) = wv; }
                            }
                        }
                    }
                    SEAM;
                    if (IN_PH) { PHV
#ifdef NAIVE_MLA
#pragma unroll 1
                        for (int u = bx; u < BATCH * MH * 32; u += G) { const int qt = 31 - u / (BATCH * MH), bh = u % (BATCH * MH); mla_attn_naive_unit(QB, KVB, MO, bh / MH, bh % MH, qt, tid); }
#else
                        const int vcu = (G % 8 == 0) ? (bx % 8) * (G / 8) + bx / 8 : bx;
#pragma unroll 1
                        for (int u = vcu; u < REP_MLA * BATCH * MH * 16; u += G) {
                            const int v = u & 255, i = (u >> 8) & 3, bh = v >> 2, s = v & 3, b = bh / MH, h = bh % MH;
                            const int qb = (i == 0) ? s : (i == 1) ? 7 - s : (i == 2) ? 8 + s : 15 - s;
                            fa::Desc dsc;
                            dsc.Q = QB + (size_t)(b * SEQ + 256 * qb) * NQ + h * QKD; dsc.qs = NQ;
                            dsc.K = KVB + (size_t)(b * SEQ) * NKV + h * KVROW; dsc.ks = NKV;
                            dsc.V = dsc.K + NOPE; dsc.vs = NKV; dsc.KPE = KPE + (size_t)(b * SEQ) * (MH * ROPE) + h * ROPE; dsc.kps = MH * ROPE;
                            dsc.O = MO + (size_t)(b * SEQ + 256 * qb) * D + h * VD; dsc.os = D;
                            dsc.LSE = nullptr; dsc.lses = 0;
                            dsc.Q0 = 256 * qb; dsc.t_lo = 0; dsc.t_hi = 4 * qb + 4; dsc.W = 1 << 30; dsc.slope2 = 0.f;
                            fa::unit<QKD, false>(ldsp, dsc);
                        }
#endif
                    }
                    SEAM;
                    if (IN_PH) { PHV pg8::Gemm g{MO, (const bf16*)(ws + WS_MWO), M, D, MH * VD}; pg8::StaticOrder S; S.init(M, D, G, bx);
                        pg8::EpiRes E{xout, xout, D, 1.0f}; pg8::gemm_phase<pg8::EpiRes, pg8::StaticOrder, true, true>(ldsp, g, S, E); }
                    SEAM;
                } else {
                    bf16* QKV = (bf16*)(ws + WS_QKV); bf16* DOB = (bf16*)(ws + WS_DOUT);
                    if (IN_PH) for (int rep_ = 0; rep_ < REP_QKV; ++rep_) { PHV pg8::Gemm g{XN, (const bf16*)(ws + WS_DQKV), M, NQKV, D}; pg8::StaticOrder S; S.init(M, NQKV, G, bx);
                        pg8::EpiQKNorm E{QKV, NQKV, args.in[I_DGQN], args.in[I_DGKN], (PG8_LAS float*)(ldsp + LDS_PS), 0.08838834764831845f * LOG2E};
                        pg8::gemm_phase<pg8::EpiQKNorm, pg8::StaticOrder, true, true>(ldsp, g, S, E); }
                    SEAM;
#ifdef NAIVE_DIL
                    if (IN_PH) { PHV
#pragma unroll 1
                        for (int u = bx; u < (M / 128) * DH; u += G) dil_attn_naive_unit(QKV, DOB, u / DH, u % DH, tid);
                    }
                    SEAM;
#else
                    bf16* OG01 = (bf16*)(ws + WS_XN); bf16* OG2 = (bf16*)(ws + WS_DOUT + 32 * MiB); float* LSEB = (float*)(ws + WS_DOUT + 64 * MiB);
                    if (IN_PH) { PHV
#pragma unroll 1
                        for (int u0 = bx; u0 < REP_DIL * DG * BATCH * DH * 16; u0 += G) { const int u = u0 % (DG * BATCH * DH * 16);
                            const int g = u >> 9, rem = u & 511, b = rem >> 7, h = (rem >> 4) & 7, k = rem & 15;
                            const int sh = 2 * g, dil = 1 << sh;
                            const int blk = (g == 0) ? k : (g == 1) ? (k & 3) : 0, res = (g == 0) ? 0 : (g == 1) ? (k >> 2) : k;
                            const int Q0 = 256 * blk; const size_t tok0 = (size_t)b * SEQ + res;
                            fa::Desc dsc;
                            dsc.Q = QKV + (tok0 + (size_t)dil * Q0) * NQKV + g * DO + h * DHD; dsc.qs = (long)dil * NQKV;
                            dsc.K = QKV + tok0 * NQKV + 3072 + g * DO + h * DHD; dsc.ks = (long)dil * NQKV;
                            dsc.V = dsc.K + 3072; dsc.vs = (long)dil * NQKV; dsc.KPE = nullptr; dsc.kps = 0;
                            bf16* og = (g < 2) ? OG01 + (size_t)g * M * DO : OG2;
                            dsc.O = og + (tok0 + (size_t)dil * Q0) * DO + h * DHD; dsc.os = (long)dil * DO;
                            dsc.LSE = LSEB + (size_t)g * M * DH + (tok0 + (size_t)dil * Q0) * DH + h; dsc.lses = dil * DH;
                            dsc.Q0 = Q0; dsc.t_lo = (Q0 >= 128) ? (Q0 - 128) / 64 : 0; dsc.t_hi = (Q0 + 256) / 64; dsc.W = 128;
                            dsc.slope2 = __builtin_amdgcn_exp2f(-(float)(g * DH + h + 1) * (1.0f / 3.0f)) * (float)dil * LOG2E;
                            fa::unit<DHD, true>(ldsp, dsc);
                        }
                    }
                    SEAM;
                    if (IN_PH) { PHV
                        for (int m = gw; m < M; m += NGW) {
                            const int h = lane >> 3;
                            const float l0 = LSEB[(size_t)m * DH + h], l1 = LSEB[(size_t)(M + m) * DH + h], l2 = LSEB[(size_t)(2 * M + m) * DH + h];
                            const float mx = fmaxf(l0, fmaxf(l1, l2));
                            float w0 = __builtin_amdgcn_exp2f(l0 - mx), w1 = __builtin_amdgcn_exp2f(l1 - mx), w2 = __builtin_amdgcn_exp2f(l2 - mx);
                            const float rs = 1.0f / (w0 + w1 + w2); w0 *= rs; w1 *= rs; w2 *= rs;
                            const v4u* a0 = (const v4u*)(OG01 + (size_t)m * DO) + 2 * lane; const v4u* a1 = (const v4u*)(OG01 + (size_t)(M + m) * DO) + 2 * lane; const v4u* a2 = (const v4u*)(OG2 + (size_t)m * DO) + 2 * lane;
                            v4u* op = (v4u*)(DOB + (size_t)m * DO) + 2 * lane;
#pragma unroll
                            for (int c = 0; c < 2; ++c) { float x0[8], x1[8], x2[8]; unpack8(a0[c], x0); unpack8(a1[c], x1); unpack8(a2[c], x2);
                                float y[8];
#pragma unroll
                                for (int e = 0; e < 8; ++e) y[e] = w0 * x0[e] + w1 * x1[e] + w2 * x2[e];
                                v4u wv; wv.x = pk2(y[0], y[1]); wv.y = pk2(y[2], y[3]); wv.z = pk2(y[4], y[5]); wv.w = pk2(y[6], y[7]); op[c] = wv; }
                        }
                    }
                    SEAM;
#endif
                    if (IN_PH) { PHV pg8::Gemm g{DOB, (const bf16*)(ws + WS_DWO), M, D, DO}; pg8::StaticOrder S; S.init(M, D, G, bx);
                        pg8::EpiRes E{xout, xout, D, 1.0f}; pg8::gemm_phase<pg8::EpiRes, pg8::StaticOrder, true, true>(ldsp, g, S, E); }
                    SEAM;
                }
            }
        }
    }
    for (int es_ = 0; es_ < EXTRA_SYNC; ++es_) xcd_barrier(bar);
#undef IN_PH
#undef SEAM
}

extern "C" void kernel_launch(void* const* d_in, const int* in_sizes, int n_in, void* d_out, int out_size, void* d_ws, size_t ws_size, hipStream_t stream) {
    static int grid = 0;
    if (grid == 0) {
        if (n_in != 20 || out_size != M * D || ws_size < WS_END) { fprintf(stderr, "kernel_launch: unexpected sizes n_in %d out %d ws %zu (need %zu)\n", n_in, out_size, ws_size, (size_t)WS_END); grid = -1; return; }
        int dev = 0, cus = 0, per_cu = 0;
        hipGetDevice(&dev); hipDeviceGetAttribute(&cus, hipDeviceAttributeMultiprocessorCount, dev);
        if (hipFuncSetAttribute((const void*)mega_fwd, hipFuncAttributeMaxDynamicSharedMemorySize, LDS_BYTES) != hipSuccess) { fprintf(stderr, "kernel_launch: hipFuncSetAttribute failed\n"); grid = -1; return; }
        if (hipOccupancyMaxActiveBlocksPerMultiprocessor(&per_cu, (const void*)mega_fwd, NWAVES * 64, LDS_BYTES) != hipSuccess || per_cu < 1) { fprintf(stderr, "kernel_launch: occupancy query says %d\n", per_cu); per_cu = 1; }
        (void)hipGetLastError();
        grid = cus * 1;
        fprintf(stderr, "kernel_launch: cus %d per_cu %d grid %d\n", cus, per_cu, grid);
    }
    if (grid < 0) return;
    if (hipMemsetAsync(d_ws, 0, 16384, stream) != hipSuccess) { fprintf(stderr, "kernel_launch: memset failed\n"); return; }
    Args a{};
    for (int i = 0; i < 20; ++i) a.in[i] = (const float*)d_in[i];
    a.out = (float*)d_out; a.ws = (unsigned char*)d_ws; a.ph_lo = 0; a.ph_hi = 1000;
    void* kargs[] = {&a};
    hipError_t e = hipLaunchCooperativeKernel((const void*)mega_fwd, dim3(grid), dim3(NWAVES * 64), kargs, LDS_BYTES, stream);
    if (e != hipSuccess) fprintf(stderr, "kernel_launch: cooperative launch failed: %s (grid %d)\n", hipGetErrorString(e), grid);
}
```
